# Optimizing an MI355X kernel written in HIP

```python
import math
import jax, jax.numpy as jnp
from jax import lax
import numpy as np

D_MODEL = 1024
BATCH = 4
SEQ = 4096
DEPTH = 2

ATT_HEADS = 8
ATT_HEAD_DIM = 64
ATT_WIDTH = ATT_HEADS * ATT_HEAD_DIM
DILATED_PATTERNS = ((128, 1), (512, 4), (2048, 16))
ATT_BLOCK = 128
ROPE_THETA = 500000.0
ROPE_DIM = ATT_HEAD_DIM // 4

MLSTM_HEADS = 4
MLSTM_HEAD_DIM = 128
MLSTM_WIDTH = MLSTM_HEADS * MLSTM_HEAD_DIM
MLSTM_CHUNK = 64
CONV_WIDTH = 4
FORGET_BIAS = 3.0

D_FF = 4 * D_MODEL
NORM_EPS = 1e-6

COL_AQ = 0
COL_AK = COL_AQ + ATT_WIDTH
COL_AV = COL_AK + ATT_WIDTH
COL_MQ = COL_AV + ATT_WIDTH
COL_MK = COL_MQ + MLSTM_WIDTH
COL_MV = COL_MK + MLSTM_WIDTH
COL_MO = COL_MV + MLSTM_WIDTH
COL_MI = COL_MO + MLSTM_WIDTH
COL_MF = COL_MI + MLSTM_HEADS
COL_GA = COL_MF + MLSTM_HEADS
COL_GB = COL_GA + D_MODEL
D_IN = COL_GB + D_MODEL

kernel_name = "hybrid_dilated_attn_mlstm_gated_block"


def rms_norm(x, w):
    xf = x.astype(jnp.float32)
    y = xf * lax.rsqrt(jnp.mean(xf * xf, axis=-1, keepdims=True) + NORM_EPS)
    return (y * w.astype(jnp.float32)).astype(x.dtype)


def rope_tables(positions):
    inv_freq = ROPE_THETA ** (-jnp.arange(0, ROPE_DIM, 2, dtype=jnp.float32) / ROPE_DIM)
    ang = positions.astype(jnp.float32)[..., None] * inv_freq
    return jnp.cos(ang)[:, :, None, :], jnp.sin(ang)[:, :, None, :]


def apply_partial_rope(t, cos, sin):
    half = ROPE_DIM // 2
    t1 = t[..., :half]
    t2 = t[..., half:ROPE_DIM]
    return jnp.concatenate([t1 * cos - t2 * sin, t2 * cos + t1 * sin, t[..., ROPE_DIM:]], axis=-1)


def dilated_window_attention(q, k, v, window, dilation):
    B, S, H, Dh = q.shape
    span = window // dilation
    L = S // dilation
    nb = -(-L // ATT_BLOCK)
    Lp = nb * ATT_BLOCK
    BD = B * dilation

    def to_sub(t):
        return t.reshape(B, L, dilation, H, Dh).transpose(0, 2, 1, 3, 4).reshape(BD, L, H, Dh)

    qs, ks, vs = to_sub(q), to_sub(k), to_sub(v)
    qb = jnp.pad(qs, ((0, 0), (0, Lp - L), (0, 0), (0, 0))).reshape(BD, nb, ATT_BLOCK, H, Dh)

    def key_blocks(t):
        tp = jnp.pad(t, ((0, 0), (ATT_BLOCK, Lp - L), (0, 0), (0, 0)))
        tp = tp.reshape(BD, nb + 1, ATT_BLOCK, H, Dh)
        return jnp.concatenate([tp[:, :-1], tp[:, 1:]], axis=2)

    kb, vb = key_blocks(ks), key_blocks(vs)
    blk = jnp.arange(nb)[:, None, None]
    qa = jnp.arange(ATT_BLOCK)[None, :, None]
    kc = jnp.arange(2 * ATT_BLOCK)[None, None, :]
    dist = qa + ATT_BLOCK - kc
    key_idx = blk * ATT_BLOCK - ATT_BLOCK + kc
    mask = (dist >= 0) & (dist <= span) & (key_idx >= 0)

    s = jnp.einsum('bnqhd,bnkhd->bnhqk', qb, kb) * (Dh ** -0.5)
    s = jnp.where(mask[None, :, None], s, -jnp.inf)
    m = jnp.max(s, axis=-1, keepdims=True)
    p = jnp.exp(s - m)
    l = jnp.sum(p, axis=-1)
    o = jnp.einsum('bnhqk,bnkhd->bnqhd', p, vb) / jnp.transpose(l, (0, 1, 3, 2))[..., None]
    lse = jnp.transpose(m[..., 0] + jnp.log(l), (0, 1, 3, 2))

    o = o.reshape(BD, Lp, H, Dh)[:, :L].reshape(B, dilation, L, H, Dh)
    o = o.transpose(0, 2, 1, 3, 4).reshape(B, S, H, Dh)
    lse = lse.reshape(BD, Lp, H)[:, :L].reshape(B, dilation, L, H)
    lse = lse.transpose(0, 2, 1, 3).reshape(B, S, H)
    return o, lse


def dilated_mixture_attention(q, k, v):
    outs, lses = [], []
    for window, dilation in DILATED_PATTERNS:
        o, lse = dilated_window_attention(q, k, v, window, dilation)
        outs.append(o)
        lses.append(lse)
    wts = jax.nn.softmax(jnp.stack(lses), axis=0)
    return jnp.einsum('gbsh,gbshd->bshd', wts, jnp.stack(outs))


def causal_short_conv(u, w, b):
    S = u.shape[1]
    up = jnp.pad(u, ((0, 0), (CONV_WIDTH - 1, 0), (0, 0)))
    out = b
    for j in range(CONV_WIDTH):
        out = out + w[j] * up[:, j:j + S]
    return out


def mlstm_chunkwise(q, k, v, ig, fg):
    B, S, H, D = q.shape
    L = MLSTM_CHUNK
    NC = S // L

    def chunks(t):
        return t.reshape(B, NC, L, H, D).transpose(0, 3, 1, 2, 4)

    def gchunks(t):
        return t.reshape(B, NC, L, H).transpose(0, 3, 1, 2)

    q = chunks(q) * (D ** -0.5)
    k = chunks(k)
    v = chunks(v)
    ig = gchunks(ig)
    lf = gchunks(jax.nn.log_sigmoid(fg))
    bcum = jnp.cumsum(lf, axis=-1)
    g = bcum[..., -1]

    a = g[..., None] - bcum + ig
    m_loc = jnp.max(a, axis=-1)
    wk = jnp.exp(a - m_loc[..., None])
    kv_c = jnp.einsum('bhcl,bhclk,bhclv->bhckv', wk, k, v)
    n_c = jnp.einsum('bhcl,bhclk->bhck', wk, k)

    def step(carry, xs):
        C, n, m = carry
        g_c, ml, kv, nn = xs
        m_new = jnp.maximum(g_c + m, ml)
        decay = jnp.exp(g_c + m - m_new)
        inj = jnp.exp(ml - m_new)
        C_new = decay[..., None, None] * C + inj[..., None, None] * kv
        n_new = decay[..., None] * n + inj[..., None] * nn
        return (C_new, n_new, m_new), (C, n, m)

    init = (jnp.zeros((B, H, D, D), jnp.float32), jnp.zeros((B, H, D), jnp.float32),
            jnp.zeros((B, H), jnp.float32))
    xs = (g.transpose(2, 0, 1), m_loc.transpose(2, 0, 1),
          kv_c.transpose(2, 0, 1, 3, 4), n_c.transpose(2, 0, 1, 3))
    _, (C_prev, n_prev, m_prev) = lax.scan(step, init, xs)
    C_prev = C_prev.transpose(1, 2, 0, 3, 4)
    n_prev = n_prev.transpose(1, 2, 0, 3)
    m_prev = m_prev.transpose(1, 2, 0)

    causal = jnp.tril(jnp.ones((L, L), dtype=bool))
    dmat = bcum[..., :, None] - bcum[..., None, :] + ig[..., None, :]
    dmat = jnp.where(causal, dmat, -jnp.inf)
    m_inter = bcum + m_prev[..., None]
    m_t = jnp.maximum(jnp.max(dmat, axis=-1), m_inter)
    p = jnp.exp(dmat - m_t[..., None]) * jnp.einsum('bhcld,bhcsd->bhcls', q, k)
    w_inter = jnp.exp(m_inter - m_t)
    num = (w_inter[..., None] * jnp.einsum('bhcld,bhcdv->bhclv', q, C_prev)
           + jnp.einsum('bhcls,bhcsv->bhclv', p, v))
    den = w_inter * jnp.einsum('bhcld,bhcd->bhcl', q, n_prev) + jnp.sum(p, axis=-1)
    h = num / jnp.maximum(jnp.abs(den), jnp.exp(-m_t))[..., None]
    return h.transpose(0, 2, 3, 1, 4).reshape(B, S, H, D)


def hybrid_layer(x, cos, sin, norm_mix_w, w_in, b_in, conv_w, conv_b, mlstm_norm_w,
                 w_proj_att, w_proj_mlstm, w_out, norm_mlp_w, w_ff1, w_ff2):
    B, S, _ = x.shape
    f32 = jnp.float32
    h = rms_norm(x, norm_mix_w)
    z = h @ w_in + b_in

    aq = z[..., COL_AQ:COL_AK].astype(f32).reshape(B, S, ATT_HEADS, ATT_HEAD_DIM)
    ak = z[..., COL_AK:COL_AV].astype(f32).reshape(B, S, ATT_HEADS, ATT_HEAD_DIM)
    av = z[..., COL_AV:COL_MQ].astype(f32).reshape(B, S, ATT_HEADS, ATT_HEAD_DIM)
    aq = apply_partial_rope(aq, cos, sin)
    ak = apply_partial_rope(ak, cos, sin)
    ya = dilated_mixture_attention(aq, ak, av).reshape(B, S, ATT_WIDTH).astype(x.dtype)

    qk = jax.nn.silu(causal_short_conv(z[..., COL_MQ:COL_MV].astype(f32),
                                       conv_w.astype(f32), conv_b.astype(f32)))
    mq = qk[..., :MLSTM_WIDTH].reshape(B, S, MLSTM_HEADS, MLSTM_HEAD_DIM)
    mk = qk[..., MLSTM_WIDTH:].reshape(B, S, MLSTM_HEADS, MLSTM_HEAD_DIM)
    mv = z[..., COL_MV:COL_MO].astype(f32).reshape(B, S, MLSTM_HEADS, MLSTM_HEAD_DIM)
    mi = z[..., COL_MI:COL_MF].astype(f32)
    mf = z[..., COL_MF:COL_GA].astype(f32)
    hm = mlstm_chunkwise(mq, mk, mv, mi, mf)
    hm = hm * lax.rsqrt(jnp.mean(hm * hm, axis=-1, keepdims=True) + NORM_EPS)
    hm = hm.reshape(B, S, MLSTM_WIDTH) * mlstm_norm_w.astype(f32)
    yb = (jax.nn.sigmoid(z[..., COL_MO:COL_MI].astype(f32)) * hm).astype(x.dtype)

    ga = jax.nn.sigmoid(z[..., COL_GA:COL_GB])
    gb = jax.nn.sigmoid(z[..., COL_GB:D_IN])
    mixed = ga * (ya @ w_proj_att) + gb * (yb @ w_proj_mlstm)
    x = x + mixed @ w_out

    h2 = rms_norm(x, norm_mlp_w)
    x = x + jnp.square(jax.nn.relu(h2 @ w_ff1)) @ w_ff2
    return x


def setup_inputs(seed: int = 0) -> dict:
    key = jax.random.key(seed)
    ks = jax.random.split(key, 16)
    nrm = jax.random.normal
    x = nrm(ks[0], (BATCH, SEQ, D_MODEL), jnp.float32)
    offsets = jax.random.randint(ks[1], (BATCH, 1), 0, 1024, dtype=jnp.int32)
    positions = offsets + jnp.arange(SEQ, dtype=jnp.int32)[None, :]
    norm_mix_w = 1.0 + 0.05 * nrm(ks[2], (DEPTH, D_MODEL), jnp.float32)
    w_in = nrm(ks[3], (DEPTH, D_MODEL, D_IN), jnp.float32) * D_MODEL ** -0.5
    b_in = 0.02 * nrm(ks[4], (DEPTH, D_IN), jnp.float32)
    b_in = b_in.at[:, COL_MF:COL_GA].add(FORGET_BIAS)
    conv_w = nrm(ks[5], (DEPTH, CONV_WIDTH, 2 * MLSTM_WIDTH), jnp.float32) * CONV_WIDTH ** -0.5
    conv_b = 0.02 * nrm(ks[6], (DEPTH, 2 * MLSTM_WIDTH), jnp.float32)
    mlstm_norm_w = 1.0 + 0.05 * nrm(ks[7], (DEPTH, MLSTM_WIDTH), jnp.float32)
    w_proj_att = nrm(ks[8], (DEPTH, ATT_WIDTH, D_MODEL), jnp.float32) * ATT_WIDTH ** -0.5
    w_proj_mlstm = nrm(ks[9], (DEPTH, MLSTM_WIDTH, D_MODEL), jnp.float32) * MLSTM_WIDTH ** -0.5
    w_out = nrm(ks[10], (DEPTH, D_MODEL, D_MODEL), jnp.float32) * D_MODEL ** -0.5
    norm_mlp_w = 1.0 + 0.05 * nrm(ks[11], (DEPTH, D_MODEL), jnp.float32)
    w_ff1 = nrm(ks[12], (DEPTH, D_MODEL, D_FF), jnp.float32) * D_MODEL ** -0.5
    w_ff2 = nrm(ks[13], (DEPTH, D_FF, D_MODEL), jnp.float32) * (0.5 * D_FF ** -0.5)
    final_norm_w = 1.0 + 0.05 * nrm(ks[14], (D_MODEL,), jnp.float32)
    return {"x": x, "positions": positions, "norm_mix_w": norm_mix_w, "w_in": w_in,
            "b_in": b_in, "conv_w": conv_w, "conv_b": conv_b, "mlstm_norm_w": mlstm_norm_w,
            "w_proj_att": w_proj_att, "w_proj_mlstm": w_proj_mlstm, "w_out": w_out,
            "norm_mlp_w": norm_mlp_w, "w_ff1": w_ff1, "w_ff2": w_ff2,
            "final_norm_w": final_norm_w}


def reference(x, positions, norm_mix_w, w_in, b_in, conv_w, conv_b, mlstm_norm_w,
              w_proj_att, w_proj_mlstm, w_out, norm_mlp_w, w_ff1, w_ff2, final_norm_w):
    cos, sin = rope_tables(positions)
    for l in range(DEPTH):
        x = hybrid_layer(x, cos, sin, norm_mix_w[l], w_in[l], b_in[l], conv_w[l], conv_b[l],
                         mlstm_norm_w[l], w_proj_att[l], w_proj_mlstm[l], w_out[l],
                         norm_mlp_w[l], w_ff1[l], w_ff2[l])
    return rms_norm(x, final_norm_w)
```

```cpp
#include <hip/hip_runtime.h>
#include <cstdio>
#include <cstdint>
constexpr int T_ = 16384, DM_ = 1024, SEQ_ = 4096, NINP_ = 5888, FF_ = 4096;
namespace pg8 {
#define PG8_LAS __attribute__((address_space(3)))
typedef unsigned short bf16_t;
typedef short bf16x8 __attribute__((ext_vector_type(8)));
typedef float f32x4 __attribute__((ext_vector_type(4)));
typedef unsigned u32x4 __attribute__((ext_vector_type(4)));
constexpr int BM = 256, BK = 64, HALF = 128, HTB = HALF * BK * 2  , STAGE_BYTES = 8 * HTB, NXCD = 8, WGM = 8;

__host__ __device__ __forceinline__ int lds_byte(int r, int c) { const int st = (r >> 4) * 2 + (c >> 5), rr = r & 15, cc = c & 31, ob = rr * 64 + cc * 2; return st * 1024 + (ob ^ (((ob >> 9) & 1) << 5)); }
__host__ __device__ __forceinline__ void stage_rc(int b, int& R, int& C) { const int st = b / 1024, sb = b % 1024, swz = sb ^ (((sb >> 9) & 1) << 5); R = (st >> 1) * 16 + swz / 64; C = (st & 1) * 32 + (swz % 64) / 2; }
__host__ __device__ __forceinline__ int perm32(int rho) { const int n = rho >> 4, i = rho & 15; return 8 * (i >> 2) + 4 * n + (i & 3); }

struct Unit { int pm, pn; };
struct Gemm { const bf16_t* A; const bf16_t* Bt; int M, N, K; };

struct StaticOrder {
    int nM, nN, nwg, G, c;
    __host__ __device__ void init(int M, int N, int G_, int c_) { nM = M / BM; nN = N / BM; nwg = nM * nN; G = G_; c = c_; }
    __host__ __device__ bool next(int i, Unit& u) const {
        const long L = (long)i * G + c; if (L >= nwg) return false;
        int wgid = (int)L; { const int q = nwg / NXCD, r = nwg % NXCD, xcd = wgid % NXCD, off = wgid / NXCD; wgid = (xcd < r ? xcd * (q + 1) : r * (q + 1) + (xcd - r) * q) + off; }
        const int nig = WGM * nN, gid = wgid / nig, fm = gid * WGM, gsz = (nM - fm) < WGM ? (nM - fm) : WGM;
        u.pm = fm + ((wgid % nig) % gsz); u.pn = (wgid % nig) / gsz; return true;
    }
    __device__ __forceinline__ void a_ready(const Unit&) const {}
    __device__ __forceinline__ void done(const Unit&) const {}
};

typedef float f32x2 __attribute__((ext_vector_type(2)));
typedef __bf16 bf16x2v __attribute__((ext_vector_type(2)));
__device__ __forceinline__ unsigned cvt_pk_bf16(float lo, float hi) { f32x2 v = {lo, hi}; bf16x2v b = __builtin_convertvector(v, bf16x2v); return __builtin_bit_cast(unsigned, b); }
__device__ __forceinline__ float bflo(unsigned w) { return __uint_as_float(w << 16); }
__device__ __forceinline__ float bfhi(unsigned w) { return __uint_as_float(w & 0xffff0000u); }
__device__ __forceinline__ u32x4 pack8(const f32x4 a, const f32x4 b) { u32x4 w; w.x = cvt_pk_bf16(a[0], a[1]); w.y = cvt_pk_bf16(a[2], a[3]); w.z = cvt_pk_bf16(b[0], b[1]); w.w = cvt_pk_bf16(b[2], b[3]); return w; }
__device__ __forceinline__ float sigmoidf_(float x) { return 1.0f / (1.0f + __expf(-x)); }


struct EpiInProj {
    static constexpr bool PERM = true, AFTER_DRAIN = false;
    bf16_t* zbase; float* gates; const float* ss; const float* bias; const float* rope;
    __device__ __forceinline__ void operator()(const f32x4 (&acc)[2][2][4][2], const Unit& u, int wr, int wc, int fr, int fq) const {
        const int pn = u.pn; const int row0 = u.pm * BM + wr * 64 + fr; const int bcol0 = pn * BM + wc * 32 + 8 * fq;
        f32x4 bv[2][2];
#pragma unroll
        for (int bj = 0; bj < 2; ++bj)
#pragma unroll
            for (int n = 0; n < 2; ++n) bv[bj][n] = *(const f32x4*)(bias + bcol0 + bj * HALF + 4 * n);
        if (pn < 14) {
            const int sec = pn >> 1; bf16_t* base = zbase + (size_t)sec * ((size_t)T_ * 512); const int col0 = (pn & 1) * 256 + wc * 32 + 8 * fq;
            const bool isq = pn < 2, rp = pn < 4; const bool rlane = ((wc & 1) == 0) && (fq < 2); const float sgn = (fq == 0) ? -1.f : 1.f;
#pragma unroll
            for (int ai = 0; ai < 2; ++ai)
#pragma unroll
                for (int m = 0; m < 4; ++m) { const int row = row0 + ai * HALF + m * 16;
                    const f32x4 p = *(const f32x4*)(ss + (size_t)row * 4); const float rs = rsqrtf(((p[0] + p[1]) + (p[2] + p[3])) * (1.0f / 1024.0f) + 1e-6f);
                    f32x4 c0, c1, s0, s1;
                    if (rp) { const float* rr = rope + (size_t)row * 16; c0 = *(const f32x4*)(rr); c1 = *(const f32x4*)(rr + 4); s0 = *(const f32x4*)(rr + 8); s1 = *(const f32x4*)(rr + 12); }
#pragma unroll
                    for (int bj = 0; bj < 2; ++bj) { f32x4 v0 = acc[ai][bj][m][0] * rs + bv[bj][0], v1 = acc[ai][bj][m][1] * rs + bv[bj][1];
                        if (rp) { f32x4 q0, q1;
#pragma unroll
                            for (int i = 0; i < 4; ++i) { q0[i] = __shfl_xor(v0[i], 16); q1[i] = __shfl_xor(v1[i], 16); }
                            if (rlane) { v0 = v0 * c0 + (q0 * s0) * sgn; v1 = v1 * c1 + (q1 * s1) * sgn; }
                            if (isq) { v0 = v0 * 0.18033688011112042f; v1 = v1 * 0.18033688011112042f; } }
                        *(u32x4*)(base + (size_t)row * 512 + col0 + bj * HALF) = pack8(v0, v1); } }
        } else if (pn < 22) {
            const int q = pn - 14; bf16_t* base = zbase + (size_t)7 * ((size_t)T_ * 512) + (size_t)(q >> 2) * ((size_t)T_ * 1024); const int col0 = (q & 3) * 256 + wc * 32 + 8 * fq;
#pragma unroll
            for (int ai = 0; ai < 2; ++ai)
#pragma unroll
                for (int m = 0; m < 4; ++m) { const int row = row0 + ai * HALF + m * 16;
                    const f32x4 p = *(const f32x4*)(ss + (size_t)row * 4); const float rs = rsqrtf(((p[0] + p[1]) + (p[2] + p[3])) * (1.0f / 1024.0f) + 1e-6f);
#pragma unroll
                    for (int bj = 0; bj < 2; ++bj) { f32x4 v0 = acc[ai][bj][m][0] * rs + bv[bj][0], v1 = acc[ai][bj][m][1] * rs + bv[bj][1];
#pragma unroll
                        for (int i = 0; i < 4; ++i) { v0[i] = sigmoidf_(v0[i]); v1[i] = sigmoidf_(v1[i]); }
                        *(u32x4*)(base + (size_t)row * 1024 + col0 + bj * HALF) = pack8(v0, v1); } }
        } else {
            if (wc == 0 && fq == 0) {
#pragma unroll
                for (int ai = 0; ai < 2; ++ai)
#pragma unroll
                    for (int m = 0; m < 4; ++m) { const int row = row0 + ai * HALF + m * 16;
                        const f32x4 p = *(const f32x4*)(ss + (size_t)row * 4); const float rs = rsqrtf(((p[0] + p[1]) + (p[2] + p[3])) * (1.0f / 1024.0f) + 1e-6f);
                        *(f32x4*)(gates + (size_t)row * 8) = acc[ai][0][m][0] * rs + bv[0][0]; *(f32x4*)(gates + (size_t)row * 8 + 4) = acc[ai][0][m][1] * rs + bv[0][1]; }
            }
        }
    }
};
struct EpiFF1 {
    static constexpr bool PERM = true, AFTER_DRAIN = false;
    bf16_t* H; const float* ss;
    __device__ __forceinline__ void operator()(const f32x4 (&acc)[2][2][4][2], const Unit& u, int wr, int wc, int fr, int fq) const {
        const int row0 = u.pm * BM + wr * 64 + fr, col0 = u.pn * BM + wc * 32 + 8 * fq;
#pragma unroll
        for (int ai = 0; ai < 2; ++ai)
#pragma unroll
            for (int m = 0; m < 4; ++m) { const int row = row0 + ai * HALF + m * 16;
                const f32x4 p = *(const f32x4*)(ss + (size_t)row * 4); const float rs = rsqrtf(((p[0] + p[1]) + (p[2] + p[3])) * (1.0f / 1024.0f) + 1e-6f);
#pragma unroll
                for (int bj = 0; bj < 2; ++bj) { f32x4 v0 = acc[ai][bj][m][0] * rs, v1 = acc[ai][bj][m][1] * rs;
#pragma unroll
                    for (int i = 0; i < 4; ++i) { const float a = fmaxf(v0[i], 0.f), b = fmaxf(v1[i], 0.f); v0[i] = a * a; v1[i] = b * b; }
                    *(u32x4*)(H + (size_t)row * FF_ + col0 + bj * HALF) = pack8(v0, v1); } }
    }
};
struct EpiX1 {
    static constexpr bool PERM = true, AFTER_DRAIN = false;
    bf16_t* G;
    __device__ __forceinline__ void operator()(const f32x4 (&acc)[2][2][4][2], const Unit& u, int wr, int wc, int fr, int fq) const {
        const int row0 = u.pm * BM + wr * 64 + fr, col0 = u.pn * BM + wc * 32 + 8 * fq;
#pragma unroll
        for (int ai = 0; ai < 2; ++ai)
#pragma unroll
            for (int m = 0; m < 4; ++m) { const int row = row0 + ai * HALF + m * 16;
#pragma unroll
                for (int bj = 0; bj < 2; ++bj) { u32x4* p = (u32x4*)(G + (size_t)row * 1024 + col0 + bj * HALF); const u32x4 g = *p;
                    const f32x4 a0 = acc[ai][bj][m][0], a1 = acc[ai][bj][m][1];
                    f32x4 v0 = {bflo(g.x) * a0[0], bfhi(g.x) * a0[1], bflo(g.y) * a0[2], bfhi(g.y) * a0[3]}, v1 = {bflo(g.z) * a1[0], bfhi(g.z) * a1[1], bflo(g.w) * a1[2], bfhi(g.w) * a1[3]};
                    *p = pack8(v0, v1); } }
    }
};
struct EpiX2 {
    static constexpr bool PERM = true, AFTER_DRAIN = false;
    bf16_t* MIX; const bf16_t* GB;
    __device__ __forceinline__ void operator()(const f32x4 (&acc)[2][2][4][2], const Unit& u, int wr, int wc, int fr, int fq) const {
        const int row0 = u.pm * BM + wr * 64 + fr, col0 = u.pn * BM + wc * 32 + 8 * fq;
#pragma unroll
        for (int ai = 0; ai < 2; ++ai)
#pragma unroll
            for (int m = 0; m < 4; ++m) { const int row = row0 + ai * HALF + m * 16;
#pragma unroll
                for (int bj = 0; bj < 2; ++bj) { const size_t off = (size_t)row * 1024 + col0 + bj * HALF; u32x4* p = (u32x4*)(MIX + off); const u32x4 t = *p; const u32x4 g = *(const u32x4*)(GB + off);
                    const f32x4 a0 = acc[ai][bj][m][0], a1 = acc[ai][bj][m][1];
                    f32x4 v0 = {bflo(t.x) + bflo(g.x) * a0[0], bfhi(t.x) + bfhi(g.x) * a0[1], bflo(t.y) + bflo(g.y) * a0[2], bfhi(t.y) + bfhi(g.y) * a0[3]};
                    f32x4 v1 = {bflo(t.z) + bflo(g.z) * a1[0], bfhi(t.z) + bfhi(g.z) * a1[1], bflo(t.w) + bflo(g.w) * a1[2], bfhi(t.w) + bfhi(g.w) * a1[3]};
                    *p = pack8(v0, v1); } }
    }
};
struct EpiResid {
    static constexpr bool PERM = true, AFTER_DRAIN = true;
    const float* base; float* out; bf16_t* xb; float* ss;
    __device__ __forceinline__ void fused(f32x4 (&acc)[2][2][4][2], const Unit& u, int wr, int wc, int fr, int fq, PG8_LAS unsigned char* lds, int wid, int lane) const {
        PG8_LAS float* P = (PG8_LAS float*)lds;
        const int row0 = u.pm * BM + wr * 64 + fr, col0 = u.pn * BM + wc * 32 + 8 * fq;
#pragma unroll
        for (int ai = 0; ai < 2; ++ai)
#pragma unroll
            for (int m = 0; m < 4; ++m) { const int row = row0 + ai * HALF + m * 16; float sq = 0.f;
#pragma unroll
                for (int bj = 0; bj < 2; ++bj) { const size_t off = (size_t)row * 1024 + col0 + bj * HALF;
                    const f32x4 v0 = acc[ai][bj][m][0] + *(const f32x4*)(base + off), v1 = acc[ai][bj][m][1] + *(const f32x4*)(base + off + 4);
                    *(f32x4*)(out + off) = v0; *(f32x4*)(out + off + 4) = v1; *(u32x4*)(xb + off) = pack8(v0, v1);
                    sq += (v0[0] * v0[0] + v0[1] * v0[1]) + (v0[2] * v0[2] + v0[3] * v0[3]) + (v1[0] * v1[0] + v1[1] * v1[1]) + (v1[2] * v1[2] + v1[3] * v1[3]); }
                sq += __shfl_xor(sq, 16); sq += __shfl_xor(sq, 32);
                if (fq == 0) P[(ai * HALF + wr * 64 + m * 16 + fr) * 4 + wc] = sq; }
        asm volatile("s_waitcnt lgkmcnt(0)" ::: "memory"); __builtin_amdgcn_s_barrier(); asm volatile("" ::: "memory");
        const int t = wid * 64 + lane;
        if (t < 256) { const float s = (P[t * 4 + 0] + P[t * 4 + 1]) + (P[t * 4 + 2] + P[t * 4 + 3]); ss[(size_t)(u.pm * BM + t) * 4 + u.pn] = s; }
        asm volatile("s_waitcnt lgkmcnt(0)" ::: "memory"); __builtin_amdgcn_s_barrier(); asm volatile("" ::: "memory");
    }
};

template <class Epi, class Sched, bool ALIGN_EPI = false, bool SP2 = false>
__device__ __forceinline__ void gemm_phase(PG8_LAS unsigned char* lds, const Gemm g, const Sched& S, const Epi& E) {
    int tid_l = threadIdx.x; asm volatile("" : "+v"(tid_l));
    const int tid = tid_l, wid = __builtin_amdgcn_readfirstlane(tid >> 6), lane = tid & 63, wr = wid >> 2, wc = wid & 3, fr = lane & 15, fq = lane >> 4;
    const int K = g.K, nt = K / BK;
    unsigned voffA[2], voffB[2];
#pragma unroll
    for (int i = 0; i < 2; ++i) { int R, C; stage_rc(tid * 16 + i * 8192, R, C); const int Rb = Epi::PERM ? ((R & ~31) + perm32(R & 31)) : R;
        voffA[i] = (unsigned)(R * K + C) * 2u; voffB[i] = (unsigned)(Rb * K + C) * 2u; }
    const size_t kstep = (size_t)(BK * 2);
    const size_t hstep = (size_t)HALF * K * 2;
    const size_t tstep = 2 * hstep;
    const unsigned ldsw = (unsigned)wid * 1024u;
    const int aoff = lds_byte(wr * 64 + fr, fq * 8), boff = lds_byte(wc * 32 + fr, fq * 8);
#define PG8_SA(b, h) (((b) * 2 + (h)) * HTB)
#define PG8_SB(b, h) ((4 + (b) * 2 + (h)) * HTB)
#define PG8_STAGE(bufoff, gbase, voff) do { _Pragma("unroll") for (int _i = 0; _i < 2; ++_i) \
        __builtin_amdgcn_global_load_lds((const unsigned*)((const char*)(gbase) + (voff)[_i]), (PG8_LAS unsigned*)(lds + (bufoff) + ldsw + _i * 8192), 16, 0, 0); } while (0)
#define PG8_LDA(dst, b, h) do { _Pragma("unroll") for (int m = 0; m < 4; ++m) _Pragma("unroll") for (int k = 0; k < 2; ++k) dst[m][k] = *(const PG8_LAS bf16x8*)(lds + PG8_SA(b, h) + aoff + m * 2048 + k * 1024); } while (0)
#define PG8_LDB(dst, b, h) do { _Pragma("unroll") for (int n = 0; n < 2; ++n) _Pragma("unroll") for (int k = 0; k < 2; ++k) dst[n][k] = *(const PG8_LAS bf16x8*)(lds + PG8_SB(b, h) + boff + n * 2048 + k * 1024); } while (0)
#define PG8_MMA(ai, bj, At, Bt) do { __builtin_amdgcn_s_setprio(1); _Pragma("unroll") for (int m = 0; m < 4; ++m) _Pragma("unroll") for (int n = 0; n < 2; ++n) _Pragma("unroll") for (int k = 0; k < 2; ++k) \
        acc[ai][bj][m][n] = __builtin_amdgcn_mfma_f32_16x16x32_bf16(Bt[n][k], At[m][k], acc[ai][bj][m][n], 0, 0, 0); __builtin_amdgcn_s_setprio(0); } while (0)
#define PG8_WAIT_V(n) asm volatile("s_waitcnt vmcnt(" #n ")" ::: "memory")
#define PG8_WAIT_L(n) asm volatile("s_waitcnt lgkmcnt(" #n ")" ::: "memory")
#define PG8_BAR __builtin_amdgcn_s_barrier()
#define PG8_SCHED __builtin_amdgcn_sched_barrier(0)
    Unit cur, nxt; int ui = 0;
    if (!S.next(0, cur)) return;
    f32x4 acc[2][2][4][2];
#pragma unroll
    for (int a = 0; a < 2; ++a)
#pragma unroll
        for (int b = 0; b < 2; ++b)
#pragma unroll
            for (int m = 0; m < 4; ++m)
#pragma unroll
                for (int n = 0; n < 2; ++n) acc[a][b][m][n] = (f32x4){0.f, 0.f, 0.f, 0.f};
    bf16x8 At[4][2], B0[2][2], B1[2][2];
    const char* cA = (const char*)g.A + (size_t)cur.pm * tstep; const char* cB = (const char*)g.Bt + (size_t)cur.pn * tstep;
    S.a_ready(cur);
    if constexpr (SP2) {
        PG8_STAGE(PG8_SB(0, 0), cB, voffB); PG8_STAGE(PG8_SB(0, 1), cB + hstep, voffB); PG8_STAGE(PG8_SA(0, 0), cA, voffA); PG8_STAGE(PG8_SA(0, 1), cA + hstep, voffA);
        if (wr == 1) PG8_BAR;
        PG8_WAIT_V(2); PG8_BAR;
        PG8_STAGE(PG8_SB(1, 0), cB + kstep, voffB); PG8_STAGE(PG8_SA(1, 0), cA + kstep, voffA); PG8_STAGE(PG8_SB(1, 1), cB + hstep + kstep, voffB);
        PG8_WAIT_V(6); PG8_BAR;
    } else {
        PG8_STAGE(PG8_SB(0, 0), cB, voffB); PG8_STAGE(PG8_SA(0, 0), cA, voffA); PG8_STAGE(PG8_SB(0, 1), cB + hstep, voffB); PG8_STAGE(PG8_SA(0, 1), cA + hstep, voffA);
        if (wr == 1) PG8_BAR;
        PG8_WAIT_V(4); PG8_BAR;
        PG8_STAGE(PG8_SB(1, 0), cB + kstep, voffB); PG8_STAGE(PG8_SA(1, 0), cA + kstep, voffA); PG8_STAGE(PG8_SB(1, 1), cB + hstep + kstep, voffB);
        PG8_WAIT_V(6); PG8_BAR;
    }
    for (;;) {
        const bool has_next = S.next(ui + 1, nxt);
        const char* nA = has_next ? (const char*)g.A + (size_t)nxt.pm * tstep : cA; const char* nB = has_next ? (const char*)g.Bt + (size_t)nxt.pn * tstep : cB;
        for (int t = 0; t < nt; t += 2) {
            const bool last = (t == nt - 2);
            const char* a1 = cA + (size_t)(t + 1) * kstep;
            const char* a2 = last ? nA : cA + (size_t)(t + 2) * kstep; const char* b2 = last ? nB : cB + (size_t)(t + 2) * kstep;
            const char* a3 = a2 + kstep; const char* b3 = b2 + kstep;
            if (last && has_next) S.a_ready(nxt);
            if constexpr (SP2) {
            PG8_LDB(B0, 0, 0); PG8_LDB(B1, 0, 1); PG8_SCHED; PG8_LDA(At, 0, 0); PG8_STAGE(PG8_SA(1, 1), a1 + hstep, voffA);
            PG8_WAIT_V(8); PG8_WAIT_L(0); PG8_BAR; PG8_MMA(0, 0, At, B0); PG8_MMA(0, 1, At, B1); PG8_BAR; PG8_SCHED;
            PG8_LDA(At, 0, 1); PG8_STAGE(PG8_SB(0, 0), b2, voffB); PG8_STAGE(PG8_SB(0, 1), b2 + hstep, voffB); PG8_STAGE(PG8_SA(0, 0), a2, voffA);
            PG8_WAIT_V(8); PG8_WAIT_L(0); PG8_BAR; PG8_MMA(1, 0, At, B0); PG8_MMA(1, 1, At, B1); PG8_BAR; PG8_SCHED;
            PG8_LDB(B0, 1, 0); PG8_LDB(B1, 1, 1); PG8_SCHED; PG8_LDA(At, 1, 0); PG8_STAGE(PG8_SA(0, 1), a2 + hstep, voffA);
            PG8_WAIT_V(8); PG8_WAIT_L(0); PG8_BAR; PG8_MMA(0, 0, At, B0); PG8_MMA(0, 1, At, B1); PG8_BAR; PG8_SCHED;
            PG8_LDA(At, 1, 1); PG8_STAGE(PG8_SB(1, 0), b3, voffB); PG8_STAGE(PG8_SB(1, 1), b3 + hstep, voffB); PG8_STAGE(PG8_SA(1, 0), a3, voffA);
            PG8_WAIT_V(8); PG8_WAIT_L(0); PG8_BAR; PG8_MMA(1, 0, At, B0); PG8_MMA(1, 1, At, B1); PG8_BAR; PG8_SCHED;
            } else {
            PG8_LDB(B0, 0, 0); PG8_SCHED; PG8_LDA(At, 0, 0); PG8_STAGE(PG8_SA(1, 1), a1 + hstep, voffA);
            PG8_WAIT_L(8); PG8_BAR; PG8_WAIT_L(0); PG8_MMA(0, 0, At, B0); PG8_BAR; PG8_SCHED;
            PG8_LDB(B1, 0, 1); PG8_STAGE(PG8_SB(0, 0), b2, voffB);
            PG8_BAR; PG8_WAIT_L(0); PG8_MMA(0, 1, At, B1); PG8_BAR;
            PG8_LDA(At, 0, 1); PG8_STAGE(PG8_SA(0, 0), a2, voffA);
            PG8_BAR; PG8_WAIT_L(0); PG8_MMA(1, 0, At, B0); PG8_BAR; PG8_SCHED;
            PG8_STAGE(PG8_SB(0, 1), b2 + hstep, voffB);
            PG8_WAIT_V(6); PG8_BAR; PG8_MMA(1, 1, At, B1); PG8_BAR;
            PG8_LDB(B0, 1, 0); PG8_SCHED; PG8_LDA(At, 1, 0); PG8_STAGE(PG8_SA(0, 1), a2 + hstep, voffA);
            PG8_WAIT_L(8); PG8_BAR; PG8_WAIT_L(0); PG8_MMA(0, 0, At, B0); PG8_BAR; PG8_SCHED;
            PG8_LDB(B1, 1, 1); PG8_STAGE(PG8_SB(1, 0), b3, voffB);
            PG8_BAR; PG8_WAIT_L(0); PG8_MMA(0, 1, At, B1); PG8_BAR;
            PG8_LDA(At, 1, 1); PG8_STAGE(PG8_SA(1, 0), a3, voffA);
            PG8_BAR; PG8_WAIT_L(0); PG8_MMA(1, 0, At, B0); PG8_BAR; PG8_SCHED;
            PG8_STAGE(PG8_SB(1, 1), b3 + hstep, voffB);
            PG8_WAIT_V(6); PG8_BAR; PG8_MMA(1, 1, At, B1); PG8_BAR;
            }
        }
        if constexpr (ALIGN_EPI) { if (wr == 0) PG8_BAR; }
        if constexpr (!Epi::AFTER_DRAIN) { E(acc, cur, wr, wc, fr, fq); S.done(cur); }
        if (!has_next) break;
#pragma unroll
        for (int a = 0; a < 2; ++a)
#pragma unroll
            for (int b = 0; b < 2; ++b)
#pragma unroll
                for (int m = 0; m < 4; ++m)
#pragma unroll
                    for (int n = 0; n < 2; ++n) acc[a][b][m][n] = (f32x4){0.f, 0.f, 0.f, 0.f};
        cur = nxt; cA = nA; cB = nB; ++ui;
        if constexpr (ALIGN_EPI) { if (wr == 1) PG8_BAR; }
    }
    PG8_WAIT_V(0);
    if constexpr (!ALIGN_EPI) { if (wr == 0) PG8_BAR; }
    PG8_BAR;
    if constexpr (Epi::AFTER_DRAIN) { E.fused(acc, cur, wr, wc, fr, fq, lds, wid, lane); S.done(cur); }
#undef PG8_SA
#undef PG8_SB
#undef PG8_STAGE
#undef PG8_LDA
#undef PG8_LDB
#undef PG8_MMA
#undef PG8_WAIT_V
#undef PG8_WAIT_L
#undef PG8_BAR
#undef PG8_SCHED
}
}
constexpr int NWAVES = 8;
constexpr size_t MiB = 1u << 20;
constexpr size_t WS_CTL = 0, CTL_ZERO_BYTES = 1 * MiB;
constexpr size_t WS_ROPE = 1 * MiB;
constexpr size_t WS_GATES = 2 * MiB;
constexpr size_t WS_SS1 = 3 * MiB;
constexpr size_t WS_SS2 = 4 * MiB;
constexpr size_t WS_LSE = 5 * MiB;
constexpr size_t WS_NC = 6 * MiB + 512 * 1024;
constexpr size_t WS_SC = 7 * MiB;
constexpr size_t WS_BIAS = 7 * MiB + 256 * 1024;
constexpr size_t WS_WIN = 8 * MiB;
constexpr size_t WS_PA = WS_WIN + (size_t)NINP_ * 1024 * 2;
constexpr size_t WS_PB = WS_PA + 1 * MiB;
constexpr size_t WS_WOUT = WS_PB + 1 * MiB;
constexpr size_t WS_W1 = WS_WOUT + 2 * MiB;
constexpr size_t WS_W2 = WS_W1 + 8 * MiB;
constexpr size_t WS_XB = 40 * MiB;
constexpr size_t WS_Z = 72 * MiB;
constexpr size_t SEC = 16 * MiB;
constexpr size_t WS_AQ = WS_Z, WS_AK = WS_Z + SEC, WS_AV = WS_Z + 2 * SEC, WS_MQ = WS_Z + 3 * SEC, WS_MK = WS_Z + 4 * SEC, WS_MV = WS_Z + 5 * SEC, WS_MO = WS_Z + 6 * SEC, WS_SGA = WS_Z + 7 * SEC, WS_SGB = WS_Z + 9 * SEC;
constexpr size_t WS_OG = WS_MQ;
constexpr size_t WS_YA = WS_AQ;
constexpr size_t WS_YB = WS_MO;
constexpr size_t WS_H = WS_Z;
constexpr size_t WS_END = WS_Z + 11 * SEC;
static_assert(WS_W2 + 8 * MiB <= WS_XB && WS_END <= 256 * MiB, "d_ws map");
constexpr int CW_TMO = 0, CW_CODE = 1;
constexpr int CW_BAR = 4096;
constexpr int RING_BYTES = 131072;
constexpr int LDSCTL_OFF = RING_BYTES, MISC_OFF = LDSCTL_OFF + 320;
constexpr int LDS_BYTES = 147456;
#define GAS __attribute__((address_space(1)))
#define LAS __attribute__((address_space(3)))
typedef unsigned short bf16;
typedef unsigned v4u __attribute__((ext_vector_type(4)));
typedef float f32x4 __attribute__((ext_vector_type(4)));
typedef short bf16x8 __attribute__((ext_vector_type(8)));
typedef GAS unsigned gu32;
typedef GAS unsigned long long gu64;
#define RLX_AGENT __ATOMIC_RELAXED, __HIP_MEMORY_SCOPE_AGENT
#define LDS_WAIT() asm volatile("s_waitcnt lgkmcnt(0)" ::: "memory")
#define VM_WAIT() asm volatile("s_waitcnt vmcnt(0)" ::: "memory")
__device__ __forceinline__ unsigned long long rt() { return __builtin_amdgcn_s_memrealtime(); }
__device__ __forceinline__ unsigned f2bf(float f) { unsigned u = __builtin_bit_cast(unsigned, f); return (u + 0x7fffu + ((u >> 16) & 1u)) >> 16; }
__device__ __forceinline__ unsigned pk2(float lo, float hi) { return f2bf(lo) | (f2bf(hi) << 16); }

#define XB_TMO      128
#define XB_XCNT(j)  (256  + 64 * (j))
#define XB_XSUB(j)  (1280 + 64 * (j))
#define XB_XGEN(j)  (2304 + 64 * (j))
#define XB_TOP      3328
#define XB_TOPGEN   3392
#define XCD_BAR_WORDS 3456
#define XB_SPIN_CAP (1u << 18)

__device__ __forceinline__ unsigned xb_ld(unsigned* p)              { return __hip_atomic_load(p, __ATOMIC_RELAXED, __HIP_MEMORY_SCOPE_AGENT); }
__device__ __forceinline__ unsigned xb_add(unsigned* p, unsigned v) { return __hip_atomic_fetch_add(p, v, __ATOMIC_RELAXED, __HIP_MEMORY_SCOPE_AGENT); }
__device__ __forceinline__ unsigned xb_xcc_id() { return (unsigned)__builtin_amdgcn_s_getreg((3 << 11) | 20) & 0xFu; }
#define XB_SPIN(cond, bar) do { unsigned _sp = 0; while (cond) { __builtin_amdgcn_s_sleep(1); \
    if ((++_sp & 255u) == 0u) { if (xb_ld(&(bar)[XB_TMO])) break; if (_sp > XB_SPIN_CAP) { atomicAdd(&(bar)[XB_TMO], 1u); break; } } } } while (0)

struct XcdBarrier {
    unsigned* bar; unsigned x;
    volatile LAS unsigned* st;
};

__device__ __forceinline__ XcdBarrier xcd_barrier_post(unsigned* bar, volatile LAS unsigned* st) {
    XcdBarrier b; b.bar = bar; b.x = xb_xcc_id(); b.st = st;
    if (threadIdx.x == 0) (void)xb_add(&bar[XB_XCNT(b.x)], 1u);
    return b;
}
__device__ __forceinline__ void xcd_barrier_complete(unsigned* bar, unsigned x, unsigned& nloc, unsigned& nx) {
    const unsigned G = gridDim.x * gridDim.y * gridDim.z;
    unsigned sum, cnt, mine, sp = 0u;
    for (;;) {
        sum = 0u; cnt = 0u; mine = 0u;
#pragma unroll
        for (unsigned j = 0; j < 16; ++j) { const unsigned c = xb_ld(&bar[XB_XCNT(j)]); sum += c; cnt += (c > 0u) ? 1u : 0u; mine = (j == x) ? c : mine; }
        if (sum == G) break;
        __builtin_amdgcn_s_sleep(1);
        if ((++sp & 255u) == 0u) { if (xb_ld(&bar[XB_TMO])) break; if (sp > XB_SPIN_CAP) { atomicAdd(&bar[XB_TMO], 1u); break; } }
    }
    nloc = mine > 0u ? mine : 1u; nx = cnt > 0u ? cnt : 1u;
}

__device__ __forceinline__ void xcd_barrier(const XcdBarrier& b) {
    asm volatile("s_waitcnt vmcnt(0)" ::: "memory");
    __syncthreads();
    if (threadIdx.x == 0) {
        unsigned* bar = b.bar;
        __builtin_amdgcn_s_waitcnt(0);
        unsigned nloc = b.st[0], nx = b.st[1];
        if (nloc == 0u) { xcd_barrier_complete(bar, b.x, nloc, nx); b.st[0] = nloc; b.st[1] = nx; }
        const unsigned old = xb_add(&bar[XB_XSUB(b.x)], 1u);
        const unsigned gen = old / nloc;
        if (old + 1u == (gen + 1u) * nloc) {
            __builtin_amdgcn_fence(__ATOMIC_RELEASE, "agent");
            asm volatile("s_waitcnt vmcnt(0)" ::: "memory");
            const unsigned og = xb_add(&bar[XB_TOP], 1u);
            const unsigned tg = og / nx;
            if (og + 1u == (tg + 1u) * nx) xb_add(&bar[XB_TOPGEN], 1u);
            else XB_SPIN(xb_ld(&bar[XB_TOPGEN]) == tg, bar);
            __builtin_amdgcn_fence(__ATOMIC_ACQUIRE, "agent");
            xb_add(&bar[XB_XGEN(b.x)], 1u);
            asm volatile("s_waitcnt vmcnt(0)" ::: "memory");
        } else {
            XB_SPIN(xb_ld(&bar[XB_XGEN(b.x)]) == gen, bar);
            __builtin_amdgcn_fence(__ATOMIC_ACQUIRE, "agent");
            asm volatile("s_waitcnt vmcnt(0)" ::: "memory");
        }
    }
    __syncthreads();
}

typedef short s16x4 __attribute__((ext_vector_type(4)));
typedef float f32x2 __attribute__((ext_vector_type(2)));
typedef unsigned u32x2 __attribute__((ext_vector_type(2)));
using pg8::cvt_pk_bf16; using pg8::bflo; using pg8::bfhi; using pg8::sigmoidf_;
__device__ __forceinline__ s16x4 tr16(const LAS unsigned char* p) { return __builtin_bit_cast(s16x4, __builtin_amdgcn_ds_read_tr16_b64_v4i16((LAS s16x4*)p)); }
__device__ __forceinline__ bf16x8 cat8(s16x4 a, s16x4 b) { return (bf16x8){a[0], a[1], a[2], a[3], b[0], b[1], b[2], b[3]}; }
__device__ __forceinline__ f32x4 mfma16(bf16x8 a, bf16x8 b, f32x4 c) { return __builtin_amdgcn_mfma_f32_16x16x32_bf16(a, b, c, 0, 0, 0); }
__device__ __forceinline__ float wave_sum(float v) {
#pragma unroll
    for (int o = 1; o < 64; o <<= 1) v += __shfl_xor(v, o);
    return v;
}
__device__ __forceinline__ float wave_max(float v) {
#pragma unroll
    for (int o = 1; o < 64; o <<= 1) v = fmaxf(v, __shfl_xor(v, o));
    return v;
}

#define PHASE_IDS() int tid = threadIdx.x; asm volatile("" : "+v"(tid)); int vcu = vcu_; asm volatile("" : "+s"(vcu)); const int lane = tid & 63, wave = __builtin_amdgcn_readfirstlane(tid >> 6); (void)lane; (void)wave; (void)vcu
struct Args {
    const float *x; const int* pos; const float *norm_mix_w, *w_in, *b_in, *conv_w, *conv_b, *mlstm_norm_w, *w_proj_att, *w_proj_mlstm, *w_out, *norm_mlp_w, *w_ff1, *w_ff2, *final_norm_w;
    float* out; unsigned char* ws;
};

typedef const __attribute__((address_space(4))) Args* KArgs;
__device__ __forceinline__ KArgs kargs() { KArgs p = (KArgs)__builtin_amdgcn_kernarg_segment_ptr(); asm volatile("" : "+s"(p)); return p; }

__device__ __forceinline__ int inproj_src_col(int n) { return n < 3584 ? n : (n < 5632 ? n + 8 : (n < 5640 ? n - 5632 + 3584 : -1)); }
template <bool REMAP>
__device__ __forceinline__ void transpose_item(const float* W, int K, int Nsrc, bf16* WT, int Ndst, const float* kscale, LAS float* scr, int item, int lane) {
    const int nblk = Ndst / 32, kb = item / nblk, nb = item % nblk, k0 = 64 * kb, n0 = 32 * nb;
    const int n_ = n0 + (lane & 31); const int sc = REMAP ? inproj_src_col(n_) : n_;
#pragma unroll 8
    for (int i = 0; i < 32; ++i) { const int kk = 2 * i + (lane >> 5); float v = 0.f; if (sc >= 0) v = W[(size_t)(k0 + kk) * Nsrc + sc]; if (kscale) v *= kscale[k0 + kk]; scr[kk * 33 + (lane & 31)] = v; }
    LDS_WAIT(); asm volatile("" ::: "memory");
    const int c = lane & 7;
#pragma unroll
    for (int j = 0; j < 4; ++j) { const int n = (lane >> 3) + 8 * j; const LAS float* s = scr + (8 * c) * 33 + n;
        v4u o; o.x = cvt_pk_bf16(s[0 * 33], s[1 * 33]); o.y = cvt_pk_bf16(s[2 * 33], s[3 * 33]); o.z = cvt_pk_bf16(s[4 * 33], s[5 * 33]); o.w = cvt_pk_bf16(s[6 * 33], s[7 * 33]);
        *(GAS v4u*)(WT + (size_t)(n0 + n) * K + k0 + 8 * c) = o; }
    LDS_WAIT(); asm volatile("" ::: "memory");
}
__device__ __forceinline__ void p0_weights(KArgs A, int layer, LAS unsigned char* L, int vcu_, int G) {
    PHASE_IDS();
    LAS float* scr = (LAS float*)(L + wave * 16384);
    const int gw = vcu * NWAVES + wave, NGW = G * NWAVES;
    constexpr int I_IN = 16 * (NINP_ / 32), I_P = 8 * 32, I_O = 16 * 32, I_1 = 16 * 128, I_2 = 64 * 32;
    constexpr int NITEMS = I_IN + 2 * I_P + I_O + I_1 + I_2;
    unsigned char* ws = A->ws;
    for (int it = gw; it < NITEMS; it += NGW) {
        int r = it;
        if (r < I_IN) { transpose_item<true>(A->w_in + (size_t)layer * 1024 * 5640, 1024, 5640, (bf16*)(ws + WS_WIN), NINP_, A->norm_mix_w + layer * 1024, scr, r, lane); continue; } r -= I_IN;
        if (r < I_P) { transpose_item<false>(A->w_proj_att + (size_t)layer * 512 * 1024, 512, 1024, (bf16*)(ws + WS_PA), 1024, nullptr, scr, r, lane); continue; } r -= I_P;
        if (r < I_P) { transpose_item<false>(A->w_proj_mlstm + (size_t)layer * 512 * 1024, 512, 1024, (bf16*)(ws + WS_PB), 1024, nullptr, scr, r, lane); continue; } r -= I_P;
        if (r < I_O) { transpose_item<false>(A->w_out + (size_t)layer * 1024 * 1024, 1024, 1024, (bf16*)(ws + WS_WOUT), 1024, nullptr, scr, r, lane); continue; } r -= I_O;
        if (r < I_1) { transpose_item<false>(A->w_ff1 + (size_t)layer * 1024 * 4096, 1024, 4096, (bf16*)(ws + WS_W1), 4096, A->norm_mlp_w + layer * 1024, scr, r, lane); continue; } r -= I_1;
        transpose_item<false>(A->w_ff2 + (size_t)layer * 4096 * 1024, 4096, 1024, (bf16*)(ws + WS_W2), 1024, nullptr, scr, r, lane);
    }
    float* bias = (float*)(ws + WS_BIAS);
    for (int n = vcu * 512 + tid; n < NINP_; n += G * 512) { const int sc = inproj_src_col(n); bias[n] = sc >= 0 ? A->b_in[layer * 5640 + sc] : 0.f; }
}
__device__ __forceinline__ void p0_xprep(KArgs A, int vcu_, int G) {
    PHASE_IDS();
    unsigned char* ws = A->ws;
    const int gw = vcu * NWAVES + wave, NGW = G * NWAVES;
    bf16* xb = (bf16*)(ws + WS_XB); float* ss = (float*)(ws + WS_SS1);
    for (int m = gw; m < T_; m += NGW) {
        const GAS f32x4* xr = (const GAS f32x4*)(A->x + (size_t)m * DM_) + lane; f32x4 v[4]; float s = 0.f;
#pragma unroll
        for (int j = 0; j < 4; ++j) { v[j] = xr[64 * j]; s += (v[j][0] * v[j][0] + v[j][1] * v[j][1]) + (v[j][2] * v[j][2] + v[j][3] * v[j][3]); }
        s = wave_sum(s);
        GAS u32x2* o8 = (GAS u32x2*)(xb + (size_t)m * DM_) + lane;
#pragma unroll
        for (int j = 0; j < 4; ++j) { u32x2 w; w.x = cvt_pk_bf16(v[j][0], v[j][1]); w.y = cvt_pk_bf16(v[j][2], v[j][3]); o8[64 * j] = w; }
        if (lane == 0) *(f32x4*)(ss + (size_t)m * 4) = (f32x4){s, 0.f, 0.f, 0.f};
    }
    float* rope = (float*)(ws + WS_ROPE);
    for (int i = vcu * 512 + tid; i < T_ * 8; i += G * 512) { const int tk = i >> 3, j = i & 7;
        double inv = 1.0;
#pragma unroll
        for (int k = 0; k < 7; ++k) inv *= (k < j) ? 0.19392274474868576 : 1.0;
        const double ang = (double)A->pos[tk] * inv; const double nrev = __builtin_rint(ang * 0.15915494309189535); const double r = ang - nrev * 6.283185307179586; const double r2 = r * r;
        double sn = 1.0, cs = 1.0, ts = 1.0, tc = 1.0;
#pragma unroll
        for (int k = 1; k <= 14; ++k) { tc *= -r2 / (double)((2 * k - 1) * (2 * k)); ts *= -r2 / (double)((2 * k) * (2 * k + 1)); cs += tc; sn += ts; }
        rope[tk * 16 + j] = (float)cs; rope[tk * 16 + 8 + j] = (float)(sn * r); }
}

__device__ __forceinline__ void conv_silu8(const bf16* src, size_t rowb, int tt, int col, const float* cw, const float* cb, int ch, float (&o)[8]) {
    const f32x4 b0 = *(const f32x4*)(cb + ch), b1 = *(const f32x4*)(cb + ch + 4);
    float a[8] = {b0[0], b0[1], b0[2], b0[3], b1[0], b1[1], b1[2], b1[3]};
#pragma unroll
    for (int j = 0; j < 4; ++j) { const int t2 = tt - 3 + j;
        if (t2 >= 0) { const v4u xin = *(const v4u*)(src + (rowb + t2) * 512 + col);
            const f32x4 w0 = *(const f32x4*)(cw + j * 1024 + ch), w1 = *(const f32x4*)(cw + j * 1024 + ch + 4);
            a[0] += w0[0] * bflo(xin.x); a[1] += w0[1] * bfhi(xin.x); a[2] += w0[2] * bflo(xin.y); a[3] += w0[3] * bfhi(xin.y);
            a[4] += w1[0] * bflo(xin.z); a[5] += w1[1] * bfhi(xin.z); a[6] += w1[2] * bflo(xin.w); a[7] += w1[3] * bfhi(xin.w); } }
#pragma unroll
    for (int e = 0; e < 8; ++e) o[e] = a[e] * sigmoidf_(a[e]);
}
__device__ __forceinline__ float logsigmoidf_(float x) { return fminf(x, 0.f) - log1pf(__expf(-fabsf(x))); }

constexpr int S2_V = 0, S2_K = 18432, S2_WK = 36864;
__device__ __forceinline__ void mlstm_summary_phase(KArgs A, int layer, LAS unsigned char* L, int vcu_, int G) {
    PHASE_IDS();
    unsigned char* ws = A->ws;
    const float* gates = (const float*)(ws + WS_GATES); const bf16* MK = (const bf16*)(ws + WS_MK); const bf16* MV = (const bf16*)(ws + WS_MV);
    bf16* KVC = (bf16*)(ws + WS_XB); float* NC = (float*)(ws + WS_NC); float* Gc = (float*)(ws + WS_SC); float* MLc = Gc + 1024;
    const float* cw = A->conv_w + (size_t)layer * 4096; const float* cb = A->conv_b + (size_t)layer * 1024;
    LAS float* WK = (LAS float*)(L + S2_WK);
    const int per = (1024 + G - 1) / G; const int u0 = vcu * per, u1 = (u0 + per) < 1024 ? (u0 + per) : 1024;
    const int g = lane >> 4, q = (lane & 15) >> 2, p = lane & 3;
    for (int u = u0; u < u1; ++u) {
        const int bh = u >> 6, c = u & 63, b = bh >> 2, h = bh & 3; const size_t rowb = (size_t)b * SEQ_; const int t0 = c * 64;
        __syncthreads();
        if (wave == 0) {
            const float ig = gates[(rowb + t0 + lane) * 8 + h], fg = gates[(rowb + t0 + lane) * 8 + 4 + h];
            float bc = logsigmoidf_(fg);
#pragma unroll
            for (int o = 1; o < 64; o <<= 1) { const float t = __shfl_up(bc, o); if (lane >= o) bc += t; }
            const float gt = __shfl(bc, 63); const float a = gt - bc + ig; const float ml = wave_max(a);
            WK[lane] = __expf(a - ml);
            if (lane == 0) { Gc[u] = gt; MLc[u] = ml; }
        }
        __syncthreads();
#pragma unroll
        for (int i = 0; i < 2; ++i) { const int idx = tid + 512 * i, l = idx >> 4, ch = idx & 15;
            *(LAS v4u*)(L + S2_V + l * 288 + ch * 16) = *(const v4u*)(MV + (rowb + t0 + l) * 512 + h * 128 + ch * 8);
            float o[8]; conv_silu8(MK, rowb, t0 + l, h * 128 + ch * 8, cw, cb, 512 + h * 128 + ch * 8, o);
            const float w = WK[l]; v4u kw; kw.x = cvt_pk_bf16(o[0] * w, o[1] * w); kw.y = cvt_pk_bf16(o[2] * w, o[3] * w); kw.z = cvt_pk_bf16(o[4] * w, o[5] * w); kw.w = cvt_pk_bf16(o[6] * w, o[7] * w);
            *(LAS v4u*)(L + S2_K + l * 288 + ch * 16) = kw; }
        __syncthreads();
        f32x4 acc[9];
#pragma unroll
        for (int i = 0; i < 9; ++i) acc[i] = (f32x4){0.f, 0.f, 0.f, 0.f};
        const bf16x8 ones = {0x3F80, 0x3F80, 0x3F80, 0x3F80, 0x3F80, 0x3F80, 0x3F80, 0x3F80};
#pragma unroll
        for (int ls = 0; ls < 2; ++ls) { const int r1 = 32 * ls + 8 * g + q;
            const bf16x8 bfr = cat8(tr16(L + S2_K + r1 * 288 + (16 * wave + 4 * p) * 2), tr16(L + S2_K + (r1 + 4) * 288 + (16 * wave + 4 * p) * 2));
#pragma unroll
            for (int it = 0; it < 8; ++it) { const bf16x8 afr = cat8(tr16(L + S2_V + r1 * 288 + (16 * it + 4 * p) * 2), tr16(L + S2_V + (r1 + 4) * 288 + (16 * it + 4 * p) * 2));
                acc[it] = mfma16(afr, bfr, acc[it]); }
            acc[8] = mfma16(ones, bfr, acc[8]); }
        const int kcol = 16 * wave + (lane & 15);
#pragma unroll
        for (int it = 0; it < 8; ++it)
#pragma unroll
            for (int e = 0; e < 4; ++e) { const int v = 16 * it + 4 * g + e; KVC[((size_t)u * 128 + v) * 128 + kcol] = (bf16)(cvt_pk_bf16(acc[it][e], 0.f) & 0xffffu); }
        if (g == 0) NC[(size_t)u * 128 + kcol] = acc[8][0];
    }
}
__device__ __forceinline__ void mlstm_scan_phase(KArgs A, int vcu_, int G) {
    PHASE_IDS();
    unsigned char* ws = A->ws;
    unsigned* KVC = (unsigned*)(ws + WS_XB); float* NC = (float*)(ws + WS_NC); const float* Gc = (const float*)(ws + WS_SC); const float* MLc = Gc + 1024; float* MP = (float*)(ws + WS_SC) + 2048;
    for (int idx = vcu * 512 + tid; idx < 16 * 8192; idx += G * 512) {
        const int bh = idx >> 13, e2 = idx & 8191; unsigned* p = KVC + (size_t)bh * 64 * 8192 + e2; float m = 0.f, C0 = 0.f, C1 = 0.f;
        for (int c0 = 0; c0 < 64; c0 += 8) { unsigned kv[8];
#pragma unroll
            for (int j = 0; j < 8; ++j) kv[j] = p[(size_t)(c0 + j) * 8192];
#pragma unroll
            for (int j = 0; j < 8; ++j) { const int c = c0 + j; const float gg = Gc[bh * 64 + c], ml = MLc[bh * 64 + c];
                p[(size_t)c * 8192] = cvt_pk_bf16(C0, C1); if (e2 == 0) MP[bh * 64 + c] = m;
                const float mn = fmaxf(gg + m, ml), dec = __expf(gg + m - mn), inj = __expf(ml - mn);
                C0 = dec * C0 + inj * bflo(kv[j]); C1 = dec * C1 + inj * bfhi(kv[j]); m = mn; } }
    }
    for (int idx = vcu * 512 + tid; idx < 16 * 128; idx += G * 512) {
        const int bh = idx >> 7, k = idx & 127; float* p = NC + (size_t)bh * 64 * 128 + k; float m = 0.f, n = 0.f;
        for (int c = 0; c < 64; ++c) { const float gg = Gc[bh * 64 + c], ml = MLc[bh * 64 + c]; const float nc = p[c * 128]; p[c * 128] = n;
            const float mn = fmaxf(gg + m, ml), dec = __expf(gg + m - mn), inj = __expf(ml - mn); n = dec * n + inj * nc; m = mn; }
    }
}
constexpr int S4_Q = 0, S4_K = 17408, S4_V = 34816, S4_C = 53248, S4_H = 53248, S4_G = 92416;
__device__ __forceinline__ void mlstm_output_phase(KArgs A, int layer, LAS unsigned char* L, int vcu_, int G) {
    PHASE_IDS();
    unsigned char* ws = A->ws;
    const float* gates = (const float*)(ws + WS_GATES); const bf16* MQ = (const bf16*)(ws + WS_MQ); const bf16* MK = (const bf16*)(ws + WS_MK); const bf16* MV = (const bf16*)(ws + WS_MV);
    bf16* MO = (bf16*)(ws + WS_MO); const bf16* KVC = (const bf16*)(ws + WS_XB); const float* NC = (const float*)(ws + WS_NC); const float* MP = (const float*)(ws + WS_SC) + 2048;
    const float* cw = A->conv_w + (size_t)layer * 4096; const float* cb = A->conv_b + (size_t)layer * 1024; const float* nw = A->mlstm_norm_w + layer * 512;
    LAS float* U = (LAS float*)(L + S4_G); LAS float* MROW = U + 64; LAS float* WINT = U + 128; LAS float* ENEG = U + 192; LAS float* DEN = U + 256;
    const int per = (1024 + G - 1) / G; const int u0 = vcu * per, u1 = (u0 + per) < 1024 ? (u0 + per) : 1024;
    const int g = lane >> 4, q = (lane & 15) >> 2, p = lane & 3, fr = lane & 15;
    const int lt = wave & 3, vh = wave >> 2;
    for (int u = u0; u < u1; ++u) {
        const int bh = u >> 6, c = u & 63, b = bh >> 2, h = bh & 3; const size_t rowb = (size_t)b * SEQ_; const int t0 = c * 64;
        __syncthreads();
        if (wave == 0) {
            const float ig = gates[(rowb + t0 + lane) * 8 + h], fg = gates[(rowb + t0 + lane) * 8 + 4 + h]; const float mp = MP[u];
            float bc = logsigmoidf_(fg);
#pragma unroll
            for (int o = 1; o < 64; o <<= 1) { const float t = __shfl_up(bc, o); if (lane >= o) bc += t; }
            const float uu = ig - bc; float pm = uu;
#pragma unroll
            for (int o = 1; o < 64; o <<= 1) { const float t = __shfl_up(pm, o); if (lane >= o) pm = fmaxf(pm, t); }
            const float M = fmaxf(pm, mp);
            U[lane] = uu; MROW[lane] = M; WINT[lane] = __expf(mp - M); ENEG[lane] = __expf(-(bc + M));
        }
#pragma unroll
        for (int i = 0; i < 2; ++i) { const int idx = tid + 512 * i, l = idx >> 4, ch = idx & 15; float o[8];
            conv_silu8(MQ, rowb, t0 + l, h * 128 + ch * 8, cw, cb, h * 128 + ch * 8, o);
            const float sc = 0.08838834764831845f; v4u w; w.x = cvt_pk_bf16(o[0] * sc, o[1] * sc); w.y = cvt_pk_bf16(o[2] * sc, o[3] * sc); w.z = cvt_pk_bf16(o[4] * sc, o[5] * sc); w.w = cvt_pk_bf16(o[6] * sc, o[7] * sc);
            *(LAS v4u*)(L + S4_Q + l * 272 + ch * 16) = w;
            conv_silu8(MK, rowb, t0 + l, h * 128 + ch * 8, cw, cb, 512 + h * 128 + ch * 8, o);
            w.x = cvt_pk_bf16(o[0], o[1]); w.y = cvt_pk_bf16(o[2], o[3]); w.z = cvt_pk_bf16(o[4], o[5]); w.w = cvt_pk_bf16(o[6], o[7]);
            *(LAS v4u*)(L + S4_K + l * 272 + ch * 16) = w;
            *(LAS v4u*)(L + S4_V + l * 288 + ch * 16) = *(const v4u*)(MV + (rowb + t0 + l) * 512 + h * 128 + ch * 8); }
        if (tid < 128) { const int l = tid >> 1, ch = 16 + (tid & 1); *(LAS v4u*)(L + S4_V + l * 288 + ch * 16) = (v4u){(tid & 1) ? 0u : 0x3F80u, 0u, 0u, 0u}; }
#pragma unroll
        for (int i = 0; i < 4; ++i) { const int idx = tid + 512 * i, v = idx >> 4, ch = idx & 15;
            *(LAS v4u*)(L + S4_C + v * 272 + ch * 16) = *(const v4u*)(KVC + ((size_t)u * 128 + v) * 128 + ch * 8); }
        if (tid < 256) { const int v = 128 + (tid >> 4), ch = tid & 15; v4u w = (v4u){0u, 0u, 0u, 0u};
            if (v == 128) { const float* np = NC + (size_t)u * 128 + ch * 8; const f32x4 a = *(const f32x4*)np, bq = *(const f32x4*)(np + 4); w.x = cvt_pk_bf16(a[0], a[1]); w.y = cvt_pk_bf16(a[2], a[3]); w.z = cvt_pk_bf16(bq[0], bq[1]); w.w = cvt_pk_bf16(bq[2], bq[3]); }
            *(LAS v4u*)(L + S4_C + v * 272 + ch * 16) = w; }
        __syncthreads();
        bf16x8 qf[4];
#pragma unroll
        for (int ks = 0; ks < 4; ++ks) qf[ks] = *(const LAS bf16x8*)(L + S4_Q + (16 * lt + fr) * 272 + (32 * ks + 8 * g) * 2);
        const int lrow = 16 * lt + fr; const float Ml = MROW[lrow];
        bf16x8 pa[2];
#pragma unroll
        for (int sp = 0; sp < 2; ++sp) { unsigned pw[4];
#pragma unroll
            for (int hh = 0; hh < 2; ++hh) { const int st = 2 * sp + hh; f32x4 s = (f32x4){0.f, 0.f, 0.f, 0.f};
#pragma unroll
                for (int ks = 0; ks < 4; ++ks) { const bf16x8 kf = *(const LAS bf16x8*)(L + S4_K + (16 * st + fr) * 272 + (32 * ks + 8 * g) * 2); s = mfma16(kf, qf[ks], s); }
                float pv[4];
#pragma unroll
                for (int e = 0; e < 4; ++e) { const int sidx = 16 * st + 4 * g + e; pv[e] = (sidx <= lrow) ? s[e] * __expf(U[sidx] - Ml) : 0.f; }
                pw[2 * hh] = cvt_pk_bf16(pv[0], pv[1]); pw[2 * hh + 1] = cvt_pk_bf16(pv[2], pv[3]); }
            pa[sp] = __builtin_bit_cast(bf16x8, (v4u){pw[0], pw[1], pw[2], pw[3]}); }
        f32x4 acc[5]; const int vt0 = vh ? 5 : 0; const int nvt = vh ? 4 : 5;
#pragma unroll
        for (int i = 0; i < 5; ++i) { acc[i] = (f32x4){0.f, 0.f, 0.f, 0.f};
            if (i < nvt) { const int vt = vt0 + i;
#pragma unroll
                for (int ks = 0; ks < 4; ++ks) { const bf16x8 cf = *(const LAS bf16x8*)(L + S4_C + (16 * vt + fr) * 272 + (32 * ks + 8 * g) * 2); acc[i] = mfma16(qf[ks], cf, acc[i]); }
#pragma unroll
                for (int e = 0; e < 4; ++e) acc[i][e] *= WINT[16 * lt + 4 * g + e];
#pragma unroll
                for (int sp = 0; sp < 2; ++sp) { const bf16x8 vf = cat8(tr16(L + S4_V + (32 * sp + 4 * g + q) * 288 + (16 * vt + 4 * p) * 2), tr16(L + S4_V + (32 * sp + 16 + 4 * g + q) * 288 + (16 * vt + 4 * p) * 2));
                    acc[i] = mfma16(pa[sp], vf, acc[i]); } } }
        if (vh == 1 && fr == 0) {
#pragma unroll
            for (int e = 0; e < 4; ++e) DEN[16 * lt + 4 * g + e] = acc[3][e]; }
        __syncthreads();
#pragma unroll
        for (int i = 0; i < 5; ++i) { if (i < nvt && (vt0 + i) < 8) { const int vt = vt0 + i;
#pragma unroll
                for (int e = 0; e < 4; ++e) { const int l = 16 * lt + 4 * g + e; const float dn = fmaxf(fabsf(DEN[l]), ENEG[l]); *(LAS float*)(L + S4_H + l * 528 + (16 * vt + fr) * 4) = acc[i][e] / dn; } } }
        __syncthreads();
#pragma unroll
        for (int r = 0; r < 8; ++r) { const int l = 8 * wave + r; const f32x2 hv = *(const LAS f32x2*)(L + S4_H + l * 528 + lane * 8);
            const float ssq = wave_sum(hv[0] * hv[0] + hv[1] * hv[1]); const float rr = rsqrtf(ssq * (1.0f / 128.0f) + 1e-6f);
            unsigned* mp = (unsigned*)(MO + (rowb + t0 + l) * 512 + h * 128 + 2 * lane); const unsigned mo = *mp; const f32x2 nv = *(const f32x2*)(nw + h * 128 + 2 * lane);
            *mp = cvt_pk_bf16(sigmoidf_(bflo(mo)) * hv[0] * rr * nv[0], sigmoidf_(bfhi(mo)) * hv[1] * rr * nv[1]); }
    }
}

constexpr int SA_K = 0, SA_V = 36864;
__device__ __forceinline__ void attn_phase(KArgs A, LAS unsigned char* L, int vcu_, int G) {
    PHASE_IDS();
    unsigned char* ws = A->ws;
    const bf16* AQ = (const bf16*)(ws + WS_AQ); const bf16* AK = (const bf16*)(ws + WS_AK); const bf16* AV = (const bf16*)(ws + WS_AV);
    bf16* OG = (bf16*)(ws + WS_OG); float* LSE = (float*)(ws + WS_LSE);
    const int per = (3072 + G - 1) / G; const int u0 = vcu * per, u1 = (u0 + per) < 3072 ? (u0 + per) : 3072;
    const int g = lane >> 4, fr = lane & 15, q4 = (lane & 15) >> 2, p = lane & 3;
    for (int u = u0; u < u1; ++u) {
        const int gp = u >> 10, b = (u >> 8) & 3, h = (u >> 5) & 7, idx = u & 31;
        const int dsh = 2 * gp, d = 1 << dsh, nbs = 5 - dsh;
        const int r = idx >> nbs, blk = idx & ((1 << nbs) - 1);
        const size_t rowb = (size_t)b * SEQ_;
        __syncthreads();
#pragma unroll
        for (int i = 0; i < 4; ++i) { const int id2 = tid + 512 * i, kc = id2 >> 3, ch = id2 & 7; int m = 128 * (blk - 1) + kc; m = m < 0 ? 0 : m;
            const size_t off = (rowb + (size_t)m * d + r) * 512 + h * 64 + ch * 8;
            *(LAS v4u*)(L + SA_K + kc * 144 + ch * 16) = *(const v4u*)(AK + off);
            *(LAS v4u*)(L + SA_V + kc * 144 + ch * 16) = *(const v4u*)(AV + off); }
        const size_t qrow = rowb + (size_t)(128 * blk + 16 * wave + fr) * d + r;
        const bf16x8 qf0 = *(const bf16x8*)(AQ + qrow * 512 + h * 64 + 8 * g), qf1 = *(const bf16x8*)(AQ + qrow * 512 + h * 64 + 32 + 8 * g);
        __syncthreads();
        f32x4 s[9]; float mx = -INFINITY;
#pragma unroll
        for (int jt = 0; jt < 9; ++jt) { const LAS unsigned char* kp = L + SA_K + (16 * wave + 16 * jt + fr) * 144 + 16 * g;
            const bf16x8 k0 = *(const LAS bf16x8*)kp, k1 = *(const LAS bf16x8*)(kp + 64);
            f32x4 a = (f32x4){0.f, 0.f, 0.f, 0.f}; a = mfma16(k0, qf0, a); a = mfma16(k1, qf1, a);
#pragma unroll
            for (int e = 0; e < 4; ++e) { const int rel = 16 * jt + 4 * g + e - fr; const int kc = 16 * wave + 16 * jt + 4 * g + e;
                const bool ok = (rel >= 0) && (rel <= 128) && (blk > 0 || kc >= 128);
                a[e] = ok ? a[e] : -INFINITY; mx = fmaxf(mx, a[e]); }
            s[jt] = a; }
        mx = fmaxf(mx, __shfl_xor(mx, 16)); mx = fmaxf(mx, __shfl_xor(mx, 32));
        float lsum = 0.f;
#pragma unroll
        for (int jt = 0; jt < 9; ++jt)
#pragma unroll
            for (int e = 0; e < 4; ++e) { const float pe = __builtin_amdgcn_exp2f(s[jt][e] - mx); s[jt][e] = pe; lsum += pe; }
        lsum += __shfl_xor(lsum, 16); lsum += __shfl_xor(lsum, 32);
        f32x4 o[4];
#pragma unroll
        for (int dt = 0; dt < 4; ++dt) o[dt] = (f32x4){0.f, 0.f, 0.f, 0.f};
#pragma unroll
        for (int st = 0; st < 5; ++st) { const int t0 = 2 * st, t1 = (2 * st + 1) < 9 ? (2 * st + 1) : 8;
            v4u pw; pw.x = cvt_pk_bf16(s[t0][0], s[t0][1]); pw.y = cvt_pk_bf16(s[t0][2], s[t0][3]);
            if (st < 4) { pw.z = cvt_pk_bf16(s[t1][0], s[t1][1]); pw.w = cvt_pk_bf16(s[t1][2], s[t1][3]); } else { pw.z = 0u; pw.w = 0u; }
            const bf16x8 pa = __builtin_bit_cast(bf16x8, pw);
#pragma unroll
            for (int dt = 0; dt < 4; ++dt) { const s16x4 v0 = tr16(L + SA_V + (16 * wave + 16 * t0 + 4 * g + q4) * 144 + (16 * dt + 4 * p) * 2);
                const s16x4 v1 = (st < 4) ? tr16(L + SA_V + (16 * wave + 16 * t1 + 4 * g + q4) * 144 + (16 * dt + 4 * p) * 2) : v0;
                o[dt] = mfma16(pa, cat8(v0, v1), o[dt]); } }
        const float lse = mx + __builtin_amdgcn_logf(lsum);
        const float inv = 1.0f / lsum;
        float invq[4];
#pragma unroll
        for (int e = 0; e < 4; ++e) invq[e] = __shfl(inv, 4 * g + e);
        if (g == 0) LSE[((size_t)gp * T_ + qrow) * 8 + h] = lse;
#pragma unroll
        for (int e = 0; e < 4; ++e) { const size_t orow = rowb + (size_t)(128 * blk + 16 * wave + 4 * g + e) * d + r;
#pragma unroll
            for (int dt = 0; dt < 4; ++dt) OG[((size_t)gp * T_ + orow) * 512 + h * 64 + 16 * dt + fr] = (bf16)(cvt_pk_bf16(o[dt][e] * invq[e], 0.f) & 0xffffu); }
    }
}
__device__ __forceinline__ void combine_phase(KArgs A, int vcu_, int G) {
    PHASE_IDS();
    unsigned char* ws = A->ws; const bf16* OG = (const bf16*)(ws + WS_OG); const float* LSE = (const float*)(ws + WS_LSE); bf16* YA = (bf16*)(ws + WS_YA);
    for (int i = vcu * 512 + tid; i < T_ * 64; i += G * 512) { const int tk = i >> 6, ch = i & 63, h = ch >> 3;
        const float l0 = LSE[((size_t)0 * T_ + tk) * 8 + h], l1 = LSE[((size_t)1 * T_ + tk) * 8 + h], l2 = LSE[((size_t)2 * T_ + tk) * 8 + h];
        const float mm = fmaxf(l0, fmaxf(l1, l2)); float w0 = __builtin_amdgcn_exp2f(l0 - mm), w1 = __builtin_amdgcn_exp2f(l1 - mm), w2 = __builtin_amdgcn_exp2f(l2 - mm); const float iw = 1.0f / (w0 + w1 + w2); w0 *= iw; w1 *= iw; w2 *= iw;
        const v4u a = *(const v4u*)(OG + ((size_t)0 * T_ + tk) * 512 + ch * 8), bq = *(const v4u*)(OG + ((size_t)1 * T_ + tk) * 512 + ch * 8), c = *(const v4u*)(OG + ((size_t)2 * T_ + tk) * 512 + ch * 8);
        v4u o;
        o.x = cvt_pk_bf16(w0 * bflo(a.x) + w1 * bflo(bq.x) + w2 * bflo(c.x), w0 * bfhi(a.x) + w1 * bfhi(bq.x) + w2 * bfhi(c.x));
        o.y = cvt_pk_bf16(w0 * bflo(a.y) + w1 * bflo(bq.y) + w2 * bflo(c.y), w0 * bfhi(a.y) + w1 * bfhi(bq.y) + w2 * bfhi(c.y));
        o.z = cvt_pk_bf16(w0 * bflo(a.z) + w1 * bflo(bq.z) + w2 * bflo(c.z), w0 * bfhi(a.z) + w1 * bfhi(bq.z) + w2 * bfhi(c.z));
        o.w = cvt_pk_bf16(w0 * bflo(a.w) + w1 * bflo(bq.w) + w2 * bflo(c.w), w0 * bfhi(a.w) + w1 * bfhi(bq.w) + w2 * bfhi(c.w));
        *(v4u*)(YA + (size_t)tk * 512 + ch * 8) = o; }
}
__device__ __forceinline__ void final_norm_phase(KArgs A, int vcu_, int G) {
    PHASE_IDS();
    const float* ss = (const float*)(A->ws + WS_SS1); const int gw = vcu * NWAVES + wave, NGW = G * NWAVES;
    for (int m = gw; m < T_; m += NGW) { const f32x4 pp = *(const f32x4*)(ss + (size_t)m * 4); const float rs = rsqrtf(((pp[0] + pp[1]) + (pp[2] + pp[3])) * (1.0f / 1024.0f) + 1e-6f);
        f32x4* xr = (f32x4*)(A->out + (size_t)m * DM_) + lane; const f32x4* wr_ = (const f32x4*)A->final_norm_w + lane;
#pragma unroll
        for (int j = 0; j < 4; ++j) xr[64 * j] = xr[64 * j] * rs * wr_[64 * j]; }
}

__global__ void __launch_bounds__(NWAVES * 64, 2) fwd_megakernel(Args args_by_value) {
    extern __shared__ __attribute__((aligned(16))) unsigned char lds[];
    LAS unsigned char* L = (LAS unsigned char*)lds;
    volatile LAS unsigned* MISC = (volatile LAS unsigned*)(L + MISC_OFF);
    const int tid = threadIdx.x, lane = tid & 63, wave = __builtin_amdgcn_readfirstlane(tid >> 6);
    const int G = gridDim.x, bx = blockIdx.x; const int vcu = (G % 8 == 0) ? (bx % 8) * (G / 8) + bx / 8 : bx;
    gu32* ctl = (gu32*)(kargs()->ws + WS_CTL);
    for (int u = tid; u < (LDS_BYTES - LDSCTL_OFF) / 4; u += NWAVES * 64) ((LAS unsigned*)(L + LDSCTL_OFF))[u] = 0u;
    __syncthreads();
    XcdBarrier bar = xcd_barrier_post((unsigned*)(ctl + CW_BAR), MISC + 8);
#define GRID_BAR() xcd_barrier(bar)
#pragma unroll 1
    for (int layer = 0; layer < 2; ++layer) {
        p0_weights(kargs(), layer, L, vcu, G);
        if (layer == 0) p0_xprep(kargs(), vcu, G);
        GRID_BAR();
        { KArgs A = kargs(); unsigned char* ws = A->ws; pg8::bf16_t* XB = (pg8::bf16_t*)(ws + WS_XB); float* SS1 = (float*)(ws + WS_SS1); float* SS2 = (float*)(ws + WS_SS2); (void)XB; (void)SS1; (void)SS2;
          pg8::Gemm g{XB, (const pg8::bf16_t*)(ws + WS_WIN), T_, NINP_, DM_}; pg8::StaticOrder S; S.init(T_, NINP_, G, bx);
          pg8::EpiInProj E{(pg8::bf16_t*)(ws + WS_Z), (float*)(ws + WS_GATES), SS1, (const float*)(ws + WS_BIAS), (const float*)(ws + WS_ROPE)};
          pg8::gemm_phase<pg8::EpiInProj, pg8::StaticOrder, true, true>(L, g, S, E); }
        GRID_BAR();
        mlstm_summary_phase(kargs(), layer, L, vcu, G);
        GRID_BAR();
        mlstm_scan_phase(kargs(), vcu, G);
        GRID_BAR();
        mlstm_output_phase(kargs(), layer, L, vcu, G);
        GRID_BAR();
        attn_phase(kargs(), L, vcu, G);
        GRID_BAR();
        combine_phase(kargs(), vcu, G);
        GRID_BAR();
        { KArgs A = kargs(); unsigned char* ws = A->ws; pg8::bf16_t* XB = (pg8::bf16_t*)(ws + WS_XB); float* SS1 = (float*)(ws + WS_SS1); float* SS2 = (float*)(ws + WS_SS2); (void)XB; (void)SS1; (void)SS2;
          pg8::Gemm g{(const pg8::bf16_t*)(ws + WS_YA), (const pg8::bf16_t*)(ws + WS_PA), T_, DM_, 512}; pg8::StaticOrder S; S.init(T_, DM_, G, bx);
          pg8::EpiX1 E{(pg8::bf16_t*)(ws + WS_SGA)};
          pg8::gemm_phase<pg8::EpiX1, pg8::StaticOrder, true, true>(L, g, S, E); }
        VM_WAIT(); __syncthreads(); __builtin_amdgcn_fence(__ATOMIC_ACQUIRE, "agent"); VM_WAIT(); __syncthreads();
        { KArgs A = kargs(); unsigned char* ws = A->ws; pg8::bf16_t* XB = (pg8::bf16_t*)(ws + WS_XB); float* SS1 = (float*)(ws + WS_SS1); float* SS2 = (float*)(ws + WS_SS2); (void)XB; (void)SS1; (void)SS2;
          pg8::Gemm g{(const pg8::bf16_t*)(ws + WS_YB), (const pg8::bf16_t*)(ws + WS_PB), T_, DM_, 512}; pg8::StaticOrder S; S.init(T_, DM_, G, bx);
          pg8::EpiX2 E{(pg8::bf16_t*)(ws + WS_SGA), (const pg8::bf16_t*)(ws + WS_SGB)};
          pg8::gemm_phase<pg8::EpiX2, pg8::StaticOrder, true, true>(L, g, S, E); }
        GRID_BAR();
        { KArgs A = kargs(); unsigned char* ws = A->ws; pg8::bf16_t* XB = (pg8::bf16_t*)(ws + WS_XB); float* SS1 = (float*)(ws + WS_SS1); float* SS2 = (float*)(ws + WS_SS2); (void)XB; (void)SS1; (void)SS2;
          pg8::Gemm g{(const pg8::bf16_t*)(ws + WS_SGA), (const pg8::bf16_t*)(ws + WS_WOUT), T_, DM_, DM_}; pg8::StaticOrder S; S.init(T_, DM_, G, bx);
          pg8::EpiResid E{layer == 0 ? A->x : A->out, A->out, XB, SS2};
          pg8::gemm_phase<pg8::EpiResid, pg8::StaticOrder, false, true>(L, g, S, E); }
        GRID_BAR();
        { KArgs A = kargs(); unsigned char* ws = A->ws; pg8::bf16_t* XB = (pg8::bf16_t*)(ws + WS_XB); float* SS1 = (float*)(ws + WS_SS1); float* SS2 = (float*)(ws + WS_SS2); (void)XB; (void)SS1; (void)SS2;
          pg8::Gemm g{XB, (const pg8::bf16_t*)(ws + WS_W1), T_, FF_, DM_}; pg8::StaticOrder S; S.init(T_, FF_, G, bx);
          pg8::EpiFF1 E{(pg8::bf16_t*)(ws + WS_H), SS2};
          pg8::gemm_phase<pg8::EpiFF1, pg8::StaticOrder, true, true>(L, g, S, E); }
        GRID_BAR();
        { KArgs A = kargs(); unsigned char* ws = A->ws; pg8::bf16_t* XB = (pg8::bf16_t*)(ws + WS_XB); float* SS1 = (float*)(ws + WS_SS1); float* SS2 = (float*)(ws + WS_SS2); (void)XB; (void)SS1; (void)SS2;
          pg8::Gemm g{(const pg8::bf16_t*)(ws + WS_H), (const pg8::bf16_t*)(ws + WS_W2), T_, DM_, FF_}; pg8::StaticOrder S; S.init(T_, DM_, G, bx);
          pg8::EpiResid E{A->out, A->out, XB, SS1};
          pg8::gemm_phase<pg8::EpiResid, pg8::StaticOrder, false, true>(L, g, S, E); }
        GRID_BAR();
    }
    final_norm_phase(kargs(), vcu, G);
}

extern "C" void kernel_launch(void* const* d_in, const int* in_sizes, int n_in, void* d_out, int out_size, void* d_ws, size_t ws_size, hipStream_t stream) {
    static int grid = 0;
    if (grid == 0) {
        int dev = 0, cus = 0;
        if (n_in != 15 || out_size != T_ * DM_ || ws_size < WS_END) { fprintf(stderr, "kernel_launch: unexpected shapes (n_in %d, out %d, ws %zu)\n", n_in, out_size, ws_size); grid = -1; return; }
        if (hipGetDevice(&dev) != hipSuccess || hipDeviceGetAttribute(&cus, hipDeviceAttributeMultiprocessorCount, dev) != hipSuccess) { grid = -1; return; }
        if (hipFuncSetAttribute((const void*)fwd_megakernel, hipFuncAttributeMaxDynamicSharedMemorySize, LDS_BYTES) != hipSuccess) { grid = -1; return; }
        grid = cus;
    }
    if (grid < 0) return;
    (void)hipMemsetAsync((char*)d_ws + WS_CTL, 0, CTL_ZERO_BYTES, stream);
    Args a{};
    a.x = (const float*)d_in[0]; a.pos = (const int*)d_in[1]; a.norm_mix_w = (const float*)d_in[2]; a.w_in = (const float*)d_in[3]; a.b_in = (const float*)d_in[4];
    a.conv_w = (const float*)d_in[5]; a.conv_b = (const float*)d_in[6]; a.mlstm_norm_w = (const float*)d_in[7]; a.w_proj_att = (const float*)d_in[8]; a.w_proj_mlstm = (const float*)d_in[9];
    a.w_out = (const float*)d_in[10]; a.norm_mlp_w = (const float*)d_in[11]; a.w_ff1 = (const float*)d_in[12]; a.w_ff2 = (const float*)d_in[13]; a.final_norm_w = (const float*)d_in[14];
    a.out = (float*)d_out; a.ws = (unsigned char*)d_ws;
    hipLaunchKernelGGL(fwd_megakernel, dim3(grid), dim3(NWAVES * 64), LDS_BYTES, stream, a);
}
```

```cpp
#include <hip/hip_runtime.h>
#include <cstdio>
#include <cstdint>
constexpr int T_ = 16384, DM_ = 1024, SEQ_ = 4096, NINP_ = 5888, FF_ = 4096;
namespace pg8 {
#define PG8_LAS __attribute__((address_space(3)))
typedef unsigned short bf16_t;
typedef short bf16x8 __attribute__((ext_vector_type(8)));
typedef float f32x4 __attribute__((ext_vector_type(4)));
typedef unsigned u32x4 __attribute__((ext_vector_type(4)));
constexpr int BM = 256, BK = 64, HALF = 128, HTB = HALF * BK * 2  , STAGE_BYTES = 8 * HTB, NXCD = 8, WGM = 8;

__host__ __device__ __forceinline__ int lds_byte(int r, int c) { const int st = (r >> 4) * 2 + (c >> 5), rr = r & 15, cc = c & 31, ob = rr * 64 + cc * 2; return st * 1024 + (ob ^ (((ob >> 9) & 1) << 5)); }
__host__ __device__ __forceinline__ void stage_rc(int b, int& R, int& C) { const int st = b / 1024, sb = b % 1024, swz = sb ^ (((sb >> 9) & 1) << 5); R = (st >> 1) * 16 + swz / 64; C = (st & 1) * 32 + (swz % 64) / 2; }
__host__ __device__ __forceinline__ int perm32(int rho) { const int n = rho >> 4, i = rho & 15; return 8 * (i >> 2) + 4 * n + (i & 3); }

struct Unit { int pm, pn; };
struct Gemm { const bf16_t* A; const bf16_t* Bt; int M, N, K; };

struct StaticOrder {
    int nM, nN, nwg, G, c;
    __host__ __device__ void init(int M, int N, int G_, int c_) { nM = M / BM; nN = N / BM; nwg = nM * nN; G = G_; c = c_; }
    __host__ __device__ bool next(int i, Unit& u) const {
        const long L = (long)i * G + c; if (L >= nwg) return false;
        int wgid = (int)L; { const int q = nwg / NXCD, r = nwg % NXCD, xcd = wgid % NXCD, off = wgid / NXCD; wgid = (xcd < r ? xcd * (q + 1) : r * (q + 1) + (xcd - r) * q) + off; }
        const int nig = WGM * nN, gid = wgid / nig, fm = gid * WGM, gsz = (nM - fm) < WGM ? (nM - fm) : WGM;
        u.pm = fm + ((wgid % nig) % gsz); u.pn = (wgid % nig) / gsz; return true;
    }
    __device__ __forceinline__ void a_ready(const Unit&) const {}
    __device__ __forceinline__ void done(const Unit&) const {}
};

typedef float f32x2 __attribute__((ext_vector_type(2)));
typedef __bf16 bf16x2v __attribute__((ext_vector_type(2)));
__device__ __forceinline__ unsigned cvt_pk_bf16(float lo, float hi) { f32x2 v = {lo, hi}; bf16x2v b = __builtin_convertvector(v, bf16x2v); return __builtin_bit_cast(unsigned, b); }
__device__ __forceinline__ float bflo(unsigned w) { return __uint_as_float(w << 16); }
__device__ __forceinline__ float bfhi(unsigned w) { return __uint_as_float(w & 0xffff0000u); }
__device__ __forceinline__ u32x4 pack8(const f32x4 a, const f32x4 b) { u32x4 w; w.x = cvt_pk_bf16(a[0], a[1]); w.y = cvt_pk_bf16(a[2], a[3]); w.z = cvt_pk_bf16(b[0], b[1]); w.w = cvt_pk_bf16(b[2], b[3]); return w; }
__device__ __forceinline__ float sigmoidf_(float x) { return __builtin_amdgcn_rcpf(1.0f + __builtin_amdgcn_exp2f(x * -1.4426950408889634f)); }


#define EPI_FENCE() asm volatile("" ::: "memory")
__device__ __forceinline__ float rstd_of(const f32x4 p) { return rsqrtf(((p[0] + p[1]) + (p[2] + p[3])) * (1.0f / 1024.0f) + 1e-6f); }

struct EpiInProj {
    static constexpr bool PERM = true, AFTER_DRAIN = false;
    bf16_t* zbase; float* gates; const float* ss; const float* bias; const float* rope; int st;
    __device__ __forceinline__ void operator()(const f32x4 (&acc)[2][2][4][2], const Unit& u, int wr, int wc, int fr, int fq) const {
        const int pn = u.pn; const int row0 = u.pm * BM + wr * 64 + fr; const int bcol0 = pn * BM + wc * 32 + 8 * fq;
        f32x4 bv[2][2], pp[2][4];
#pragma unroll
        for (int bj = 0; bj < 2; ++bj)
#pragma unroll
            for (int n = 0; n < 2; ++n) bv[bj][n] = *(const f32x4*)(bias + bcol0 + bj * HALF + 4 * n);
#pragma unroll
        for (int ai = 0; ai < 2; ++ai)
#pragma unroll
            for (int m = 0; m < 4; ++m) pp[ai][m] = *(const f32x4*)(ss + (size_t)(row0 + ai * HALF + m * 16) * 4);
        float rs[2][4];
#pragma unroll
        for (int ai = 0; ai < 2; ++ai)
#pragma unroll
            for (int m = 0; m < 4; ++m) rs[ai][m] = rstd_of(pp[ai][m]);
        if (pn < 14) {
            const int sec = pn >> 1; bf16_t* base = zbase + (size_t)sec * ((size_t)T_ * 512); const int col0 = (pn & 1) * 256 + wc * 32 + 8 * fq;
            const bool isq = pn < 2, rp = pn < 4; const bool rlane = ((wc & 1) == 0) && (fq < 2); const float sgn = (fq == 0) ? -1.f : 1.f;
#pragma unroll
            for (int am = 0; am < 4; ++am) { const int ai = am >> 1, mh = am & 1;
                f32x4 cs[2][4];
                if (rp) {
#pragma unroll
                    for (int m2 = 0; m2 < 2; ++m2) { const float* rr = rope + (size_t)(row0 + ai * HALF + (2 * mh + m2) * 16) * 16;
#pragma unroll
                        for (int k = 0; k < 4; ++k) cs[m2][k] = *(const f32x4*)(rr + 4 * k); }
                    EPI_FENCE();
                }
#pragma unroll
                for (int m2 = 0; m2 < 2; ++m2) { const int m = 2 * mh + m2; const int row = row0 + ai * HALF + m * 16;
#pragma unroll
                    for (int bj = 0; bj < 2; ++bj) { f32x4 v0 = acc[ai][bj][m][0] * rs[ai][m] + bv[bj][0], v1 = acc[ai][bj][m][1] * rs[ai][m] + bv[bj][1];
                        if (rp) { f32x4 q0, q1;
#pragma unroll
                            for (int i = 0; i < 4; ++i) { q0[i] = __shfl_xor(v0[i], 16); q1[i] = __shfl_xor(v1[i], 16); }
                            if (rlane) { v0 = v0 * cs[m2][0] + (q0 * cs[m2][2]) * sgn; v1 = v1 * cs[m2][1] + (q1 * cs[m2][3]) * sgn; }
                            if (isq) { v0 = v0 * 0.18033688011112042f; v1 = v1 * 0.18033688011112042f; } }
                        { const u32x4 pk_ = pack8(v0, v1); if (st) *(u32x4*)(base + (size_t)row * 512 + col0 + bj * HALF) = pk_; else asm volatile("" :: "v"(pk_)); } } }
                if (rp) EPI_FENCE();
            }
        } else if (pn < 22) {
            const int q = pn - 14; bf16_t* base = zbase + (size_t)7 * ((size_t)T_ * 512) + (size_t)(q >> 2) * ((size_t)T_ * 1024); const int col0 = (q & 3) * 256 + wc * 32 + 8 * fq;
#pragma unroll
            for (int ai = 0; ai < 2; ++ai)
#pragma unroll
                for (int m = 0; m < 4; ++m) { const int row = row0 + ai * HALF + m * 16;
#pragma unroll
                    for (int bj = 0; bj < 2; ++bj) { f32x4 v0 = acc[ai][bj][m][0] * rs[ai][m] + bv[bj][0], v1 = acc[ai][bj][m][1] * rs[ai][m] + bv[bj][1];
#pragma unroll
                        for (int i = 0; i < 4; ++i) { v0[i] = sigmoidf_(v0[i]); v1[i] = sigmoidf_(v1[i]); }
                        { const u32x4 pk_ = pack8(v0, v1); if (st) *(u32x4*)(base + (size_t)row * 1024 + col0 + bj * HALF) = pk_; else asm volatile("" :: "v"(pk_)); } } }
        } else {
            if (wc == 0 && fq == 0) {
#pragma unroll
                for (int ai = 0; ai < 2; ++ai)
#pragma unroll
                    for (int m = 0; m < 4; ++m) { const int row = row0 + ai * HALF + m * 16;
                        *(f32x4*)(gates + (size_t)row * 8) = acc[ai][0][m][0] * rs[ai][m] + bv[0][0]; *(f32x4*)(gates + (size_t)row * 8 + 4) = acc[ai][0][m][1] * rs[ai][m] + bv[0][1]; }
            }
        }
    }
};
struct EpiFF1 {
    static constexpr bool PERM = true, AFTER_DRAIN = false;
    bf16_t* H; const float* ss; int mode;
    __device__ __forceinline__ void operator()(const f32x4 (&acc)[2][2][4][2], const Unit& u, int wr, int wc, int fr, int fq) const {
        const int row0 = u.pm * BM + wr * 64 + fr, col0 = u.pn * BM + wc * 32 + 8 * fq;
        f32x4 pp[2][4];
#pragma unroll
        for (int ai = 0; ai < 2; ++ai)
#pragma unroll
            for (int m = 0; m < 4; ++m) pp[ai][m] = (mode == 1) ? (f32x4){1024.f, 0.f, 0.f, 0.f} : *(const f32x4*)(ss + (size_t)(row0 + ai * HALF + m * 16) * 4);
        EPI_FENCE();
#pragma unroll
        for (int ai = 0; ai < 2; ++ai)
#pragma unroll
            for (int m = 0; m < 4; ++m) { const int row = row0 + ai * HALF + m * 16; const float rs = rstd_of(pp[ai][m]);
#pragma unroll
                for (int bj = 0; bj < 2; ++bj) { f32x4 v0 = acc[ai][bj][m][0] * rs, v1 = acc[ai][bj][m][1] * rs;
#pragma unroll
                    for (int i = 0; i < 4; ++i) { const float a = fmaxf(v0[i], 0.f), b = fmaxf(v1[i], 0.f); v0[i] = a * a; v1[i] = b * b; }
                    { const u32x4 pk_ = pack8(v0, v1); if (mode != 2) *(u32x4*)(H + (size_t)row * FF_ + col0 + bj * HALF) = pk_; else asm volatile("" :: "v"(pk_)); } } }
    }
};
struct EpiX1 {
    static constexpr bool PERM = true, AFTER_DRAIN = false;
    bf16_t* G;
    __device__ __forceinline__ void operator()(const f32x4 (&acc)[2][2][4][2], const Unit& u, int wr, int wc, int fr, int fq) const {
        const int row0 = u.pm * BM + wr * 64 + fr, col0 = u.pn * BM + wc * 32 + 8 * fq;
        u32x4 gv[2][4][2];
#pragma unroll
        for (int ai = 0; ai < 2; ++ai)
#pragma unroll
            for (int m = 0; m < 4; ++m)
#pragma unroll
                for (int bj = 0; bj < 2; ++bj) gv[ai][m][bj] = *(const u32x4*)(G + (size_t)(row0 + ai * HALF + m * 16) * 1024 + col0 + bj * HALF);
        EPI_FENCE();
#pragma unroll
        for (int ai = 0; ai < 2; ++ai)
#pragma unroll
            for (int m = 0; m < 4; ++m) { const int row = row0 + ai * HALF + m * 16;
#pragma unroll
                for (int bj = 0; bj < 2; ++bj) { const u32x4 g = gv[ai][m][bj];
                    const f32x4 a0 = acc[ai][bj][m][0], a1 = acc[ai][bj][m][1];
                    f32x4 v0 = {bflo(g.x) * a0[0], bfhi(g.x) * a0[1], bflo(g.y) * a0[2], bfhi(g.y) * a0[3]}, v1 = {bflo(g.z) * a1[0], bfhi(g.z) * a1[1], bflo(g.w) * a1[2], bfhi(g.w) * a1[3]};
                    *(u32x4*)(G + (size_t)row * 1024 + col0 + bj * HALF) = pack8(v0, v1); } }
    }
};
struct EpiX2 {
    static constexpr bool PERM = true, AFTER_DRAIN = false;
    bf16_t* MIX; const bf16_t* GB;
    __device__ __forceinline__ void operator()(const f32x4 (&acc)[2][2][4][2], const Unit& u, int wr, int wc, int fr, int fq) const {
        const int row0 = u.pm * BM + wr * 64 + fr, col0 = u.pn * BM + wc * 32 + 8 * fq;
#pragma unroll
        for (int ai = 0; ai < 2; ++ai) {
            u32x4 tv[4][2], gv[4][2];
#pragma unroll
            for (int m = 0; m < 4; ++m)
#pragma unroll
                for (int bj = 0; bj < 2; ++bj) { const size_t off = (size_t)(row0 + ai * HALF + m * 16) * 1024 + col0 + bj * HALF; tv[m][bj] = *(const u32x4*)(MIX + off); gv[m][bj] = *(const u32x4*)(GB + off); }
            EPI_FENCE();
#pragma unroll
            for (int m = 0; m < 4; ++m)
#pragma unroll
                for (int bj = 0; bj < 2; ++bj) { const size_t off = (size_t)(row0 + ai * HALF + m * 16) * 1024 + col0 + bj * HALF; const u32x4 t = tv[m][bj], g = gv[m][bj];
                    const f32x4 a0 = acc[ai][bj][m][0], a1 = acc[ai][bj][m][1];
                    f32x4 v0 = {bflo(t.x) + bflo(g.x) * a0[0], bfhi(t.x) + bfhi(g.x) * a0[1], bflo(t.y) + bflo(g.y) * a0[2], bfhi(t.y) + bfhi(g.y) * a0[3]};
                    f32x4 v1 = {bflo(t.z) + bflo(g.z) * a1[0], bfhi(t.z) + bfhi(g.z) * a1[1], bflo(t.w) + bflo(g.w) * a1[2], bfhi(t.w) + bfhi(g.w) * a1[3]};
                    *(u32x4*)(MIX + off) = pack8(v0, v1); }
            EPI_FENCE();
        }
    }
};
struct EpiResid {
    static constexpr bool PERM = true, AFTER_DRAIN = true;
    const float* base; float* out; bf16_t* xb; float* ss;
    __device__ __forceinline__ void fused(f32x4 (&acc)[2][2][4][2], const Unit& u, int wr, int wc, int fr, int fq, PG8_LAS unsigned char* lds, int wid, int lane) const {
        PG8_LAS float* P = (PG8_LAS float*)lds;
        const int row0 = u.pm * BM + wr * 64 + fr, col0 = u.pn * BM + wc * 32 + 8 * fq;
#pragma unroll
        for (int ai = 0; ai < 2; ++ai)
#pragma unroll
            for (int mh = 0; mh < 2; ++mh) {
                f32x4 b0[2][2], b1[2][2];
#pragma unroll
                for (int m2 = 0; m2 < 2; ++m2)
#pragma unroll
                    for (int bj = 0; bj < 2; ++bj) { const size_t off = (size_t)(row0 + ai * HALF + (2 * mh + m2) * 16) * 1024 + col0 + bj * HALF; b0[m2][bj] = *(const f32x4*)(base + off); b1[m2][bj] = *(const f32x4*)(base + off + 4); }
                EPI_FENCE();
#pragma unroll
                for (int m2 = 0; m2 < 2; ++m2) { const int m = 2 * mh + m2; const int row = row0 + ai * HALF + m * 16; float sq = 0.f;
#pragma unroll
                    for (int bj = 0; bj < 2; ++bj) { const size_t off = (size_t)row * 1024 + col0 + bj * HALF;
                        const f32x4 v0 = acc[ai][bj][m][0] + b0[m2][bj], v1 = acc[ai][bj][m][1] + b1[m2][bj];
                        *(f32x4*)(out + off) = v0; *(f32x4*)(out + off + 4) = v1; *(u32x4*)(xb + off) = pack8(v0, v1);
                        sq += (v0[0] * v0[0] + v0[1] * v0[1]) + (v0[2] * v0[2] + v0[3] * v0[3]) + (v1[0] * v1[0] + v1[1] * v1[1]) + (v1[2] * v1[2] + v1[3] * v1[3]); }
                    sq += __shfl_xor(sq, 16); sq += __shfl_xor(sq, 32);
                    if (fq == 0) P[(ai * HALF + wr * 64 + m * 16 + fr) * 4 + wc] = sq; }
                EPI_FENCE();
            }
        asm volatile("s_waitcnt lgkmcnt(0)" ::: "memory"); __builtin_amdgcn_s_barrier(); asm volatile("" ::: "memory");
        const int t = wid * 64 + lane;
        if (t < 256) { const float s = (P[t * 4 + 0] + P[t * 4 + 1]) + (P[t * 4 + 2] + P[t * 4 + 3]); ss[(size_t)(u.pm * BM + t) * 4 + u.pn] = s; }
        asm volatile("s_waitcnt lgkmcnt(0)" ::: "memory"); __builtin_amdgcn_s_barrier(); asm volatile("" ::: "memory");
    }
};

struct EpiNull {
    static constexpr bool PERM = true, AFTER_DRAIN = false;
    float* sink; int flag;
    __device__ __forceinline__ void operator()(const f32x4 (&acc)[2][2][4][2], const Unit& u, int wr, int wc, int fr, int fq) const {
        if (flag) {
#pragma unroll
            for (int ai = 0; ai < 2; ++ai)
#pragma unroll
                for (int m = 0; m < 4; ++m)
#pragma unroll
                    for (int bj = 0; bj < 2; ++bj) { *(f32x4*)(sink + (size_t)(u.pm * 256 + wr * 64 + fr + ai * 128 + m * 16) * 1024 + u.pn * 256 + wc * 32 + 8 * fq + bj * 128) = acc[ai][bj][m][0] + acc[ai][bj][m][1]; }
        }
    }
};

template <class Epi, class Sched, bool ALIGN_EPI = false, bool SP2 = false>
__device__ __forceinline__ void gemm_phase(PG8_LAS unsigned char* lds, const Gemm g, const Sched& S, const Epi& E) {
    int tid_l = threadIdx.x; asm volatile("" : "+v"(tid_l));
    const int tid = tid_l, wid = __builtin_amdgcn_readfirstlane(tid >> 6), lane = tid & 63, wr = wid >> 2, wc = wid & 3, fr = lane & 15, fq = lane >> 4;
    const int K = g.K, nt = K / BK;
    unsigned voffA[2], voffB[2];
#pragma unroll
    for (int i = 0; i < 2; ++i) { int R, C; stage_rc(tid * 16 + i * 8192, R, C); const int Rb = Epi::PERM ? ((R & ~31) + perm32(R & 31)) : R;
        voffA[i] = (unsigned)(R * K + C) * 2u; voffB[i] = (unsigned)(Rb * K + C) * 2u; }
    const size_t kstep = (size_t)(BK * 2);
    const size_t hstep = (size_t)HALF * K * 2;
    const size_t tstep = 2 * hstep;
    const unsigned ldsw = (unsigned)wid * 1024u;
    const int aoff = lds_byte(wr * 64 + fr, fq * 8), boff = lds_byte(wc * 32 + fr, fq * 8);
#define PG8_SA(b, h) (((b) * 2 + (h)) * HTB)
#define PG8_SB(b, h) ((4 + (b) * 2 + (h)) * HTB)
#define PG8_STAGE(bufoff, gbase, voff) do { _Pragma("unroll") for (int _i = 0; _i < 2; ++_i) \
        __builtin_amdgcn_global_load_lds((const unsigned*)((const char*)(gbase) + (voff)[_i]), (PG8_LAS unsigned*)(lds + (bufoff) + ldsw + _i * 8192), 16, 0, 0); } while (0)
#define PG8_LDA(dst, b, h) do { _Pragma("unroll") for (int m = 0; m < 4; ++m) _Pragma("unroll") for (int k = 0; k < 2; ++k) dst[m][k] = *(const PG8_LAS bf16x8*)(lds + PG8_SA(b, h) + aoff + m * 2048 + k * 1024); } while (0)
#define PG8_LDB(dst, b, h) do { _Pragma("unroll") for (int n = 0; n < 2; ++n) _Pragma("unroll") for (int k = 0; k < 2; ++k) dst[n][k] = *(const PG8_LAS bf16x8*)(lds + PG8_SB(b, h) + boff + n * 2048 + k * 1024); } while (0)
#define PG8_MMA(ai, bj, At, Bt) do { __builtin_amdgcn_s_setprio(1); _Pragma("unroll") for (int m = 0; m < 4; ++m) _Pragma("unroll") for (int n = 0; n < 2; ++n) _Pragma("unroll") for (int k = 0; k < 2; ++k) \
        acc[ai][bj][m][n] = __builtin_amdgcn_mfma_f32_16x16x32_bf16(Bt[n][k], At[m][k], acc[ai][bj][m][n], 0, 0, 0); __builtin_amdgcn_s_setprio(0); } while (0)
#define PG8_WAIT_V(n) asm volatile("s_waitcnt vmcnt(" #n ")" ::: "memory")
#define PG8_WAIT_L(n) asm volatile("s_waitcnt lgkmcnt(" #n ")" ::: "memory")
#define PG8_BAR __builtin_amdgcn_s_barrier()
#define PG8_SCHED __builtin_amdgcn_sched_barrier(0)
    Unit cur, nxt; int ui = 0;
    if (!S.next(0, cur)) return;
    f32x4 acc[2][2][4][2];
#pragma unroll
    for (int a = 0; a < 2; ++a)
#pragma unroll
        for (int b = 0; b < 2; ++b)
#pragma unroll
            for (int m = 0; m < 4; ++m)
#pragma unroll
                for (int n = 0; n < 2; ++n) acc[a][b][m][n] = (f32x4){0.f, 0.f, 0.f, 0.f};
    bf16x8 At[4][2], B0[2][2], B1[2][2];
    const char* cA = (const char*)g.A + (size_t)cur.pm * tstep; const char* cB = (const char*)g.Bt + (size_t)cur.pn * tstep;
    S.a_ready(cur);
    if constexpr (SP2) {
        PG8_STAGE(PG8_SB(0, 0), cB, voffB); PG8_STAGE(PG8_SB(0, 1), cB + hstep, voffB); PG8_STAGE(PG8_SA(0, 0), cA, voffA); PG8_STAGE(PG8_SA(0, 1), cA + hstep, voffA);
        if (wr == 1) PG8_BAR;
        PG8_WAIT_V(2); PG8_BAR;
        PG8_STAGE(PG8_SB(1, 0), cB + kstep, voffB); PG8_STAGE(PG8_SA(1, 0), cA + kstep, voffA); PG8_STAGE(PG8_SB(1, 1), cB + hstep + kstep, voffB);
        PG8_WAIT_V(6); PG8_BAR;
    } else {
        PG8_STAGE(PG8_SB(0, 0), cB, voffB); PG8_STAGE(PG8_SA(0, 0), cA, voffA); PG8_STAGE(PG8_SB(0, 1), cB + hstep, voffB); PG8_STAGE(PG8_SA(0, 1), cA + hstep, voffA);
        if (wr == 1) PG8_BAR;
        PG8_WAIT_V(4); PG8_BAR;
        PG8_STAGE(PG8_SB(1, 0), cB + kstep, voffB); PG8_STAGE(PG8_SA(1, 0), cA + kstep, voffA); PG8_STAGE(PG8_SB(1, 1), cB + hstep + kstep, voffB);
        PG8_WAIT_V(6); PG8_BAR;
    }
    for (;;) {
        const bool has_next = S.next(ui + 1, nxt);
        const char* nA = has_next ? (const char*)g.A + (size_t)nxt.pm * tstep : cA; const char* nB = has_next ? (const char*)g.Bt + (size_t)nxt.pn * tstep : cB;
        for (int t = 0; t < nt; t += 2) {
            const bool last = (t == nt - 2);
            const char* a1 = cA + (size_t)(t + 1) * kstep;
            const char* a2 = last ? nA : cA + (size_t)(t + 2) * kstep; const char* b2 = last ? nB : cB + (size_t)(t + 2) * kstep;
            const char* a3 = a2 + kstep; const char* b3 = b2 + kstep;
            if (last && has_next) S.a_ready(nxt);
            if constexpr (SP2) {
            PG8_LDB(B0, 0, 0); PG8_LDB(B1, 0, 1); PG8_SCHED; PG8_LDA(At, 0, 0); PG8_STAGE(PG8_SA(1, 1), a1 + hstep, voffA);
            PG8_WAIT_V(8); PG8_WAIT_L(0); PG8_BAR; PG8_MMA(0, 0, At, B0); PG8_MMA(0, 1, At, B1); PG8_BAR; PG8_SCHED;
            PG8_LDA(At, 0, 1); PG8_STAGE(PG8_SB(0, 0), b2, voffB); PG8_STAGE(PG8_SB(0, 1), b2 + hstep, voffB); PG8_STAGE(PG8_SA(0, 0), a2, voffA);
            PG8_WAIT_V(8); PG8_WAIT_L(0); PG8_BAR; PG8_MMA(1, 0, At, B0); PG8_MMA(1, 1, At, B1); PG8_BAR; PG8_SCHED;
            PG8_LDB(B0, 1, 0); PG8_LDB(B1, 1, 1); PG8_SCHED; PG8_LDA(At, 1, 0); PG8_STAGE(PG8_SA(0, 1), a2 + hstep, voffA);
            PG8_WAIT_V(8); PG8_WAIT_L(0); PG8_BAR; PG8_MMA(0, 0, At, B0); PG8_MMA(0, 1, At, B1); PG8_BAR; PG8_SCHED;
            PG8_LDA(At, 1, 1); PG8_STAGE(PG8_SB(1, 0), b3, voffB); PG8_STAGE(PG8_SB(1, 1), b3 + hstep, voffB); PG8_STAGE(PG8_SA(1, 0), a3, voffA);
            PG8_WAIT_V(8); PG8_WAIT_L(0); PG8_BAR; PG8_MMA(1, 0, At, B0); PG8_MMA(1, 1, At, B1); PG8_BAR; PG8_SCHED;
            } else {
            PG8_LDB(B0, 0, 0); PG8_SCHED; PG8_LDA(At, 0, 0); PG8_STAGE(PG8_SA(1, 1), a1 + hstep, voffA);
            PG8_WAIT_L(8); PG8_BAR; PG8_WAIT_L(0); PG8_MMA(0, 0, At, B0); PG8_BAR; PG8_SCHED;
            PG8_LDB(B1, 0, 1); PG8_STAGE(PG8_SB(0, 0), b2, voffB);
            PG8_BAR; PG8_WAIT_L(0); PG8_MMA(0, 1, At, B1); PG8_BAR;
            PG8_LDA(At, 0, 1); PG8_STAGE(PG8_SA(0, 0), a2, voffA);
            PG8_BAR; PG8_WAIT_L(0); PG8_MMA(1, 0, At, B0); PG8_BAR; PG8_SCHED;
            PG8_STAGE(PG8_SB(0, 1), b2 + hstep, voffB);
            PG8_WAIT_V(6); PG8_BAR; PG8_MMA(1, 1, At, B1); PG8_BAR;
            PG8_LDB(B0, 1, 0); PG8_SCHED; PG8_LDA(At, 1, 0); PG8_STAGE(PG8_SA(0, 1), a2 + hstep, voffA);
            PG8_WAIT_L(8); PG8_BAR; PG8_WAIT_L(0); PG8_MMA(0, 0, At, B0); PG8_BAR; PG8_SCHED;
            PG8_LDB(B1, 1, 1); PG8_STAGE(PG8_SB(1, 0), b3, voffB);
            PG8_BAR; PG8_WAIT_L(0); PG8_MMA(0, 1, At, B1); PG8_BAR;
            PG8_LDA(At, 1, 1); PG8_STAGE(PG8_SA(1, 0), a3, voffA);
            PG8_BAR; PG8_WAIT_L(0); PG8_MMA(1, 0, At, B0); PG8_BAR; PG8_SCHED;
            PG8_STAGE(PG8_SB(1, 1), b3 + hstep, voffB);
            PG8_WAIT_V(6); PG8_BAR; PG8_MMA(1, 1, At, B1); PG8_BAR;
            }
        }
        if constexpr (ALIGN_EPI) { if (wr == 0) PG8_BAR; }
        if constexpr (!Epi::AFTER_DRAIN) { E(acc, cur, wr, wc, fr, fq); S.done(cur); }
        if (!has_next) break;
#pragma unroll
        for (int a = 0; a < 2; ++a)
#pragma unroll
            for (int b = 0; b < 2; ++b)
#pragma unroll
                for (int m = 0; m < 4; ++m)
#pragma unroll
                    for (int n = 0; n < 2; ++n) acc[a][b][m][n] = (f32x4){0.f, 0.f, 0.f, 0.f};
        cur = nxt; cA = nA; cB = nB; ++ui;
        if constexpr (ALIGN_EPI) { if (wr == 1) PG8_BAR; }
    }
    PG8_WAIT_V(0);
    if constexpr (!ALIGN_EPI) { if (wr == 0) PG8_BAR; }
    PG8_BAR;
    if constexpr (Epi::AFTER_DRAIN) { E.fused(acc, cur, wr, wc, fr, fq, lds, wid, lane); S.done(cur); }
#undef PG8_SA
#undef PG8_SB
#undef PG8_STAGE
#undef PG8_LDA
#undef PG8_LDB
#undef PG8_MMA
#undef PG8_WAIT_V
#undef PG8_WAIT_L
#undef PG8_BAR
#undef PG8_SCHED
}
}
constexpr int NWAVES = 8;
constexpr size_t MiB = 1u << 20;
constexpr size_t WS_CTL = 0, CTL_ZERO_BYTES = 1 * MiB;
constexpr size_t WS_ROPE = 1 * MiB;
constexpr size_t WS_GATES = 2 * MiB;
constexpr size_t WS_SS1 = 3 * MiB;
constexpr size_t WS_SS2 = 4 * MiB;
constexpr size_t WS_LSE = 5 * MiB;
constexpr size_t WS_NC = 6 * MiB + 512 * 1024;
constexpr size_t WS_SC = 7 * MiB;
constexpr size_t WS_BIAS = 7 * MiB + 256 * 1024;
constexpr size_t WS_WIN = 8 * MiB;
constexpr size_t WS_PA = WS_WIN + (size_t)NINP_ * 1024 * 2;
constexpr size_t WS_PB = WS_PA + 1 * MiB;
constexpr size_t WS_WOUT = WS_PB + 1 * MiB;
constexpr size_t WS_W1 = WS_WOUT + 2 * MiB;
constexpr size_t WS_W2 = WS_W1 + 8 * MiB;
constexpr size_t WS_XB = 40 * MiB;
constexpr size_t WS_Z = 72 * MiB;
constexpr size_t SEC = 16 * MiB;
constexpr size_t WS_AQ = WS_Z, WS_AK = WS_Z + SEC, WS_AV = WS_Z + 2 * SEC, WS_MQ = WS_Z + 3 * SEC, WS_MK = WS_Z + 4 * SEC, WS_MV = WS_Z + 5 * SEC, WS_MO = WS_Z + 6 * SEC, WS_SGA = WS_Z + 7 * SEC, WS_SGB = WS_Z + 9 * SEC;
constexpr size_t WS_OG = WS_MQ;
constexpr size_t WS_YA = WS_AQ;
constexpr size_t WS_YB = WS_MO;
constexpr size_t WS_H = WS_Z;
constexpr size_t WS_END = WS_Z + 11 * SEC;
static_assert(WS_W2 + 8 * MiB <= WS_XB && WS_END <= 256 * MiB, "d_ws map");
constexpr int CW_TMO = 0, CW_CODE = 1;
constexpr int CW_BAR = 4096;
constexpr int RING_BYTES = 131072;
constexpr int LDSCTL_OFF = RING_BYTES, MISC_OFF = LDSCTL_OFF + 320;
constexpr int LDS_BYTES = 147456;
#define GAS __attribute__((address_space(1)))
#define LAS __attribute__((address_space(3)))
typedef unsigned short bf16;
typedef unsigned v4u __attribute__((ext_vector_type(4)));
typedef float f32x4 __attribute__((ext_vector_type(4)));
typedef short bf16x8 __attribute__((ext_vector_type(8)));
typedef GAS unsigned gu32;
typedef GAS unsigned long long gu64;
#define RLX_AGENT __ATOMIC_RELAXED, __HIP_MEMORY_SCOPE_AGENT
#define LDS_WAIT() asm volatile("s_waitcnt lgkmcnt(0)" ::: "memory")
#define VM_WAIT() asm volatile("s_waitcnt vmcnt(0)" ::: "memory")
__device__ __forceinline__ unsigned long long rt() { return __builtin_amdgcn_s_memrealtime(); }
__device__ __forceinline__ unsigned f2bf(float f) { unsigned u = __builtin_bit_cast(unsigned, f); return (u + 0x7fffu + ((u >> 16) & 1u)) >> 16; }
__device__ __forceinline__ unsigned pk2(float lo, float hi) { return f2bf(lo) | (f2bf(hi) << 16); }

#define XB_TMO      128
#define XB_XCNT(j)  (256  + 64 * (j))
#define XB_XSUB(j)  (1280 + 64 * (j))
#define XB_XGEN(j)  (2304 + 64 * (j))
#define XB_TOP      3328
#define XB_TOPGEN   3392
#define XCD_BAR_WORDS 3456
#define XB_SPIN_CAP (1u << 18)

__device__ __forceinline__ unsigned xb_ld(unsigned* p)              { return __hip_atomic_load(p, __ATOMIC_RELAXED, __HIP_MEMORY_SCOPE_AGENT); }
__device__ __forceinline__ unsigned xb_add(unsigned* p, unsigned v) { return __hip_atomic_fetch_add(p, v, __ATOMIC_RELAXED, __HIP_MEMORY_SCOPE_AGENT); }
__device__ __forceinline__ unsigned xb_xcc_id() { return (unsigned)__builtin_amdgcn_s_getreg((3 << 11) | 20) & 0xFu; }
#define XB_SPIN(cond, bar) do { unsigned _sp = 0; while (cond) { __builtin_amdgcn_s_sleep(1); \
    if ((++_sp & 255u) == 0u) { if (xb_ld(&(bar)[XB_TMO])) break; if (_sp > XB_SPIN_CAP) { atomicAdd(&(bar)[XB_TMO], 1u); break; } } } } while (0)

struct XcdBarrier {
    unsigned* bar; unsigned x;
    volatile LAS unsigned* st;
};

__device__ __forceinline__ XcdBarrier xcd_barrier_post(unsigned* bar, volatile LAS unsigned* st) {
    XcdBarrier b; b.bar = bar; b.x = xb_xcc_id(); b.st = st;
    if (threadIdx.x == 0) (void)xb_add(&bar[XB_XCNT(b.x)], 1u);
    return b;
}
__device__ __forceinline__ void xcd_barrier_complete(unsigned* bar, unsigned x, unsigned& nloc, unsigned& nx) {
    const unsigned G = gridDim.x * gridDim.y * gridDim.z;
    unsigned sum, cnt, mine, sp = 0u;
    for (;;) {
        sum = 0u; cnt = 0u; mine = 0u;
#pragma unroll
        for (unsigned j = 0; j < 16; ++j) { const unsigned c = xb_ld(&bar[XB_XCNT(j)]); sum += c; cnt += (c > 0u) ? 1u : 0u; mine = (j == x) ? c : mine; }
        if (sum == G) break;
        __builtin_amdgcn_s_sleep(1);
        if ((++sp & 255u) == 0u) { if (xb_ld(&bar[XB_TMO])) break; if (sp > XB_SPIN_CAP) { atomicAdd(&bar[XB_TMO], 1u); break; } }
    }
    nloc = mine > 0u ? mine : 1u; nx = cnt > 0u ? cnt : 1u;
}

__device__ __forceinline__ void xcd_barrier(const XcdBarrier& b) {
    asm volatile("s_waitcnt vmcnt(0)" ::: "memory");
    __syncthreads();
    if (threadIdx.x == 0) {
        unsigned* bar = b.bar;
        __builtin_amdgcn_s_waitcnt(0);
        unsigned nloc = b.st[0], nx = b.st[1];
        if (nloc == 0u) { xcd_barrier_complete(bar, b.x, nloc, nx); b.st[0] = nloc; b.st[1] = nx; }
        const unsigned old = xb_add(&bar[XB_XSUB(b.x)], 1u);
        const unsigned gen = old / nloc;
        if (old + 1u == (gen + 1u) * nloc) {
            __builtin_amdgcn_fence(__ATOMIC_RELEASE, "agent");
            asm volatile("s_waitcnt vmcnt(0)" ::: "memory");
            const unsigned og = xb_add(&bar[XB_TOP], 1u);
            const unsigned tg = og / nx;
            if (og + 1u == (tg + 1u) * nx) xb_add(&bar[XB_TOPGEN], 1u);
            else XB_SPIN(xb_ld(&bar[XB_TOPGEN]) == tg, bar);
            __builtin_amdgcn_fence(__ATOMIC_ACQUIRE, "agent");
            xb_add(&bar[XB_XGEN(b.x)], 1u);
            asm volatile("s_waitcnt vmcnt(0)" ::: "memory");
        } else {
            XB_SPIN(xb_ld(&bar[XB_XGEN(b.x)]) == gen, bar);
            __builtin_amdgcn_fence(__ATOMIC_ACQUIRE, "agent");
            asm volatile("s_waitcnt vmcnt(0)" ::: "memory");
        }
    }
    __syncthreads();
}

typedef short s16x4 __attribute__((ext_vector_type(4)));
typedef float f32x2 __attribute__((ext_vector_type(2)));
typedef unsigned u32x2 __attribute__((ext_vector_type(2)));
using pg8::cvt_pk_bf16; using pg8::bflo; using pg8::bfhi; using pg8::sigmoidf_;
__device__ __forceinline__ s16x4 tr16(const LAS unsigned char* p) { return __builtin_bit_cast(s16x4, __builtin_amdgcn_ds_read_tr16_b64_v4i16((LAS s16x4*)p)); }
__device__ __forceinline__ bf16x8 cat8(s16x4 a, s16x4 b) { return (bf16x8){a[0], a[1], a[2], a[3], b[0], b[1], b[2], b[3]}; }
__device__ __forceinline__ f32x4 mfma16(bf16x8 a, bf16x8 b, f32x4 c) { return __builtin_amdgcn_mfma_f32_16x16x32_bf16(a, b, c, 0, 0, 0); }
__device__ __forceinline__ float wave_sum(float v) {
#pragma unroll
    for (int o = 1; o < 64; o <<= 1) v += __shfl_xor(v, o);
    return v;
}
__device__ __forceinline__ float wave_max(float v) {
#pragma unroll
    for (int o = 1; o < 64; o <<= 1) v = fmaxf(v, __shfl_xor(v, o));
    return v;
}

#define PHASE_IDS() int tid = threadIdx.x; asm volatile("" : "+v"(tid)); int vcu = vcu_; asm volatile("" : "+s"(vcu)); const int lane = tid & 63, wave = __builtin_amdgcn_readfirstlane(tid >> 6); (void)lane; (void)wave; (void)vcu
struct Args {
    const float *x; const int* pos; const float *norm_mix_w, *w_in, *b_in, *conv_w, *conv_b, *mlstm_norm_w, *w_proj_att, *w_proj_mlstm, *w_out, *norm_mlp_w, *w_ff1, *w_ff2, *final_norm_w;
    float* out; unsigned char* ws;
};

typedef const __attribute__((address_space(4))) Args* KArgs;
__device__ __forceinline__ KArgs kargs() { KArgs p = (KArgs)__builtin_amdgcn_kernarg_segment_ptr(); asm volatile("" : "+s"(p)); return p; }

__device__ __forceinline__ int inproj_src_col(int n) { return n < 3584 ? n : (n < 5632 ? n + 8 : (n < 5640 ? n - 5632 + 3584 : -1)); }
template <bool REMAP>
__device__ __forceinline__ void transpose_item(const float* W, int K, int Nsrc, bf16* WT, int Ndst, const float* kscale, LAS float* scr, int item, int lane) {
    const int nblk = Ndst / 32, kb = item / nblk, nb = item % nblk, k0 = 64 * kb, n0 = 32 * nb;
    const int n_ = n0 + (lane & 31); const int sc = REMAP ? inproj_src_col(n_) : n_;
    float wv[32];
#pragma unroll
    for (int i = 0; i < 32; ++i) { const int kk = 2 * i + (lane >> 5); wv[i] = (sc >= 0) ? W[(size_t)(k0 + kk) * Nsrc + sc] : 0.f; }
    if (kscale) {
#pragma unroll
        for (int i = 0; i < 32; ++i) wv[i] *= kscale[k0 + 2 * i + (lane >> 5)]; }
#pragma unroll
    for (int i = 0; i < 32; ++i) { const int kk = 2 * i + (lane >> 5); scr[kk * 33 + (lane & 31)] = wv[i]; }
    LDS_WAIT(); asm volatile("" ::: "memory");
    const int c = lane & 7;
#pragma unroll
    for (int j = 0; j < 4; ++j) { const int n = (lane >> 3) + 8 * j; const LAS float* s = scr + (8 * c) * 33 + n;
        v4u o; o.x = cvt_pk_bf16(s[0 * 33], s[1 * 33]); o.y = cvt_pk_bf16(s[2 * 33], s[3 * 33]); o.z = cvt_pk_bf16(s[4 * 33], s[5 * 33]); o.w = cvt_pk_bf16(s[6 * 33], s[7 * 33]);
        *(GAS v4u*)(WT + (size_t)(n0 + n) * K + k0 + 8 * c) = o; }
    LDS_WAIT(); asm volatile("" ::: "memory");
}
__device__ __forceinline__ void p0_weights(KArgs A, int layer, LAS unsigned char* L, int vcu_, int G) {
    PHASE_IDS();
    LAS float* scr = (LAS float*)(L + wave * 16384);
    const int gw = vcu * NWAVES + wave, NGW = G * NWAVES;
    constexpr int I_IN = 16 * (NINP_ / 32), I_P = 8 * 32, I_O = 16 * 32, I_1 = 16 * 128, I_2 = 64 * 32;
    constexpr int NITEMS = I_IN + 2 * I_P + I_O + I_1 + I_2;
    unsigned char* ws = A->ws;
    for (int it = gw; it < NITEMS; it += NGW) {
        int r = it;
        if (r < I_IN) { transpose_item<true>(A->w_in + (size_t)layer * 1024 * 5640, 1024, 5640, (bf16*)(ws + WS_WIN), NINP_, A->norm_mix_w + layer * 1024, scr, r, lane); continue; } r -= I_IN;
        if (r < I_P) { transpose_item<false>(A->w_proj_att + (size_t)layer * 512 * 1024, 512, 1024, (bf16*)(ws + WS_PA), 1024, nullptr, scr, r, lane); continue; } r -= I_P;
        if (r < I_P) { transpose_item<false>(A->w_proj_mlstm + (size_t)layer * 512 * 1024, 512, 1024, (bf16*)(ws + WS_PB), 1024, nullptr, scr, r, lane); continue; } r -= I_P;
        if (r < I_O) { transpose_item<false>(A->w_out + (size_t)layer * 1024 * 1024, 1024, 1024, (bf16*)(ws + WS_WOUT), 1024, nullptr, scr, r, lane); continue; } r -= I_O;
        if (r < I_1) { transpose_item<false>(A->w_ff1 + (size_t)layer * 1024 * 4096, 1024, 4096, (bf16*)(ws + WS_W1), 4096, A->norm_mlp_w + layer * 1024, scr, r, lane); continue; } r -= I_1;
        transpose_item<false>(A->w_ff2 + (size_t)layer * 4096 * 1024, 4096, 1024, (bf16*)(ws + WS_W2), 1024, nullptr, scr, r, lane);
    }
    float* bias = (float*)(ws + WS_BIAS);
    for (int n = vcu * 512 + tid; n < NINP_; n += G * 512) { const int sc = inproj_src_col(n); bias[n] = sc >= 0 ? A->b_in[layer * 5640 + sc] : 0.f; }
}
__device__ __forceinline__ void p0_xprep(KArgs A, int vcu_, int G) {
    PHASE_IDS();
    unsigned char* ws = A->ws;
    const int gw = vcu * NWAVES + wave, NGW = G * NWAVES;
    bf16* xb = (bf16*)(ws + WS_XB); float* ss = (float*)(ws + WS_SS1);
    for (int m = gw; m < T_; m += NGW) {
        const GAS f32x4* xr = (const GAS f32x4*)(A->x + (size_t)m * DM_) + lane; f32x4 v[4]; float s = 0.f;
#pragma unroll
        for (int j = 0; j < 4; ++j) { v[j] = xr[64 * j]; s += (v[j][0] * v[j][0] + v[j][1] * v[j][1]) + (v[j][2] * v[j][2] + v[j][3] * v[j][3]); }
        s = wave_sum(s);
        GAS u32x2* o8 = (GAS u32x2*)(xb + (size_t)m * DM_) + lane;
#pragma unroll
        for (int j = 0; j < 4; ++j) { u32x2 w; w.x = cvt_pk_bf16(v[j][0], v[j][1]); w.y = cvt_pk_bf16(v[j][2], v[j][3]); o8[64 * j] = w; }
        if (lane == 0) *(f32x4*)(ss + (size_t)m * 4) = (f32x4){s, 0.f, 0.f, 0.f};
    }
    float* rope = (float*)(ws + WS_ROPE);
    for (int i = vcu * 512 + tid; i < T_ * 8; i += G * 512) { const int tk = i >> 3, j = i & 7;
        double inv = 1.0;
#pragma unroll
        for (int k = 0; k < 7; ++k) inv *= (k < j) ? 0.19392274474868576 : 1.0;
        const double ang = (double)A->pos[tk] * inv; const double nrev = __builtin_rint(ang * 0.15915494309189535); const double r = ang - nrev * 6.283185307179586; const double r2 = r * r;
        double sn = 1.0, cs = 1.0, ts = 1.0, tc = 1.0;
#pragma unroll
        for (int k = 1; k <= 14; ++k) { tc *= -r2 / (double)((2 * k - 1) * (2 * k)); ts *= -r2 / (double)((2 * k) * (2 * k + 1)); cs += tc; sn += ts; }
        rope[tk * 16 + j] = (float)cs; rope[tk * 16 + 8 + j] = (float)(sn * r); }
}

__device__ __forceinline__ void conv_silu8(const bf16* src, size_t rowb, int tt, int col, const float* cw, const float* cb, int ch, float (&o)[8]) {
    const f32x4 b0 = *(const f32x4*)(cb + ch), b1 = *(const f32x4*)(cb + ch + 4);
    float a[8] = {b0[0], b0[1], b0[2], b0[3], b1[0], b1[1], b1[2], b1[3]};
#pragma unroll
    for (int j = 0; j < 4; ++j) { const int t2 = tt - 3 + j;
        if (t2 >= 0) { const v4u xin = *(const v4u*)(src + (rowb + t2) * 512 + col);
            const f32x4 w0 = *(const f32x4*)(cw + j * 1024 + ch), w1 = *(const f32x4*)(cw + j * 1024 + ch + 4);
            a[0] += w0[0] * bflo(xin.x); a[1] += w0[1] * bfhi(xin.x); a[2] += w0[2] * bflo(xin.y); a[3] += w0[3] * bfhi(xin.y);
            a[4] += w1[0] * bflo(xin.z); a[5] += w1[1] * bfhi(xin.z); a[6] += w1[2] * bflo(xin.w); a[7] += w1[3] * bfhi(xin.w); } }
#pragma unroll
    for (int e = 0; e < 8; ++e) o[e] = a[e] * sigmoidf_(a[e]);
}
__device__ __forceinline__ float logsigmoidf_(float x) { return fminf(x, 0.f) - log1pf(__expf(-fabsf(x))); }

constexpr int S2_V = 0, S2_K = 18432, S2_WK = 36864;
__device__ __forceinline__ void mlstm_summary_phase(KArgs A, int layer, LAS unsigned char* L, int vcu_, int G) {
    PHASE_IDS();
    unsigned char* ws = A->ws;
    const float* gates = (const float*)(ws + WS_GATES); const bf16* MK = (const bf16*)(ws + WS_MK); const bf16* MV = (const bf16*)(ws + WS_MV);
    bf16* KVC = (bf16*)(ws + WS_XB); float* NC = (float*)(ws + WS_NC); float* Gc = (float*)(ws + WS_SC); float* MLc = Gc + 1024;
    const float* cw = A->conv_w + (size_t)layer * 4096; const float* cb = A->conv_b + (size_t)layer * 1024;
    LAS float* WK = (LAS float*)(L + S2_WK);
    const int per = (1024 + G - 1) / G; const int u0 = vcu * per, u1 = (u0 + per) < 1024 ? (u0 + per) : 1024;
    const int g = lane >> 4, q = (lane & 15) >> 2, p = lane & 3;
    for (int u = u0; u < u1; ++u) {
        const int bh = u >> 6, c = u & 63, b = bh >> 2, h = bh & 3; const size_t rowb = (size_t)b * SEQ_; const int t0 = c * 64;
        __syncthreads();
        if (wave == 0) {
            const float ig = gates[(rowb + t0 + lane) * 8 + h], fg = gates[(rowb + t0 + lane) * 8 + 4 + h];
            float bc = logsigmoidf_(fg);
#pragma unroll
            for (int o = 1; o < 64; o <<= 1) { const float t = __shfl_up(bc, o); if (lane >= o) bc += t; }
            const float gt = __shfl(bc, 63); const float a = gt - bc + ig; const float ml = wave_max(a);
            WK[lane] = __expf(a - ml);
            if (lane == 0) { Gc[u] = gt; MLc[u] = ml; }
        }
        __syncthreads();
#pragma unroll
        for (int i = 0; i < 2; ++i) { const int idx = tid + 512 * i, l = idx >> 4, ch = idx & 15;
            *(LAS v4u*)(L + S2_V + l * 288 + ch * 16) = *(const v4u*)(MV + (rowb + t0 + l) * 512 + h * 128 + ch * 8);
            float o[8]; conv_silu8(MK, rowb, t0 + l, h * 128 + ch * 8, cw, cb, 512 + h * 128 + ch * 8, o);
            const float w = WK[l]; v4u kw; kw.x = cvt_pk_bf16(o[0] * w, o[1] * w); kw.y = cvt_pk_bf16(o[2] * w, o[3] * w); kw.z = cvt_pk_bf16(o[4] * w, o[5] * w); kw.w = cvt_pk_bf16(o[6] * w, o[7] * w);
            *(LAS v4u*)(L + S2_K + l * 288 + ch * 16) = kw; }
        __syncthreads();
        f32x4 acc[9];
#pragma unroll
        for (int i = 0; i < 9; ++i) acc[i] = (f32x4){0.f, 0.f, 0.f, 0.f};
        const bf16x8 ones = {0x3F80, 0x3F80, 0x3F80, 0x3F80, 0x3F80, 0x3F80, 0x3F80, 0x3F80};
#pragma unroll
        for (int ls = 0; ls < 2; ++ls) { const int r1 = 32 * ls + 8 * g + q;
            const bf16x8 bfr = cat8(tr16(L + S2_K + r1 * 288 + (16 * wave + 4 * p) * 2), tr16(L + S2_K + (r1 + 4) * 288 + (16 * wave + 4 * p) * 2));
#pragma unroll
            for (int it = 0; it < 8; ++it) { const bf16x8 afr = cat8(tr16(L + S2_V + r1 * 288 + (16 * it + 4 * p) * 2), tr16(L + S2_V + (r1 + 4) * 288 + (16 * it + 4 * p) * 2));
                acc[it] = mfma16(afr, bfr, acc[it]); }
            acc[8] = mfma16(ones, bfr, acc[8]); }
        const int kcol = 16 * wave + (lane & 15);
#pragma unroll
        for (int it = 0; it < 8; ++it)
#pragma unroll
            for (int e = 0; e < 4; ++e) { const int v = 16 * it + 4 * g + e; KVC[((size_t)u * 128 + v) * 128 + kcol] = (bf16)(cvt_pk_bf16(acc[it][e], 0.f) & 0xffffu); }
        if (g == 0) NC[(size_t)u * 128 + kcol] = acc[8][0];
    }
}
__device__ __forceinline__ void mlstm_scan_phase(KArgs A, int vcu_, int G) {
    PHASE_IDS();
    unsigned char* ws = A->ws;
    unsigned* KVC = (unsigned*)(ws + WS_XB); float* NC = (float*)(ws + WS_NC); const float* Gc = (const float*)(ws + WS_SC); const float* MLc = Gc + 1024; float* MP = (float*)(ws + WS_SC) + 2048;
    for (int idx = vcu * 512 + tid; idx < 16 * 8192; idx += G * 512) {
        const int bh = idx >> 13, e2 = idx & 8191; unsigned* p = KVC + (size_t)bh * 64 * 8192 + e2; float m = 0.f, C0 = 0.f, C1 = 0.f;
        for (int c0 = 0; c0 < 64; c0 += 16) { unsigned kv[16];
#pragma unroll
            for (int j = 0; j < 16; ++j) kv[j] = p[(size_t)(c0 + j) * 8192];
#pragma unroll
            for (int j = 0; j < 16; ++j) { const int c = c0 + j; const float gg = Gc[bh * 64 + c], ml = MLc[bh * 64 + c];
                p[(size_t)c * 8192] = cvt_pk_bf16(C0, C1); if (e2 == 0) MP[bh * 64 + c] = m;
                const float mn = fmaxf(gg + m, ml), dec = __expf(gg + m - mn), inj = __expf(ml - mn);
                C0 = dec * C0 + inj * bflo(kv[j]); C1 = dec * C1 + inj * bfhi(kv[j]); m = mn; } }
    }
    for (int idx = vcu * 512 + tid; idx < 16 * 128; idx += G * 512) {
        const int bh = idx >> 7, k = idx & 127; float* p = NC + (size_t)bh * 64 * 128 + k; float m = 0.f, n = 0.f;
        for (int c = 0; c < 64; ++c) { const float gg = Gc[bh * 64 + c], ml = MLc[bh * 64 + c]; const float nc = p[c * 128]; p[c * 128] = n;
            const float mn = fmaxf(gg + m, ml), dec = __expf(gg + m - mn), inj = __expf(ml - mn); n = dec * n + inj * nc; m = mn; }
    }
}
constexpr int S4_Q = 0, S4_K = 17408, S4_V = 34816, S4_C = 53248, S4_H = 53248, S4_G = 92416;
__device__ __forceinline__ void mlstm_output_phase(KArgs A, int layer, LAS unsigned char* L, int vcu_, int G, bool do_store = true) {
    PHASE_IDS();
    unsigned char* ws = A->ws;
    const float* gates = (const float*)(ws + WS_GATES); const bf16* MQ = (const bf16*)(ws + WS_MQ); const bf16* MK = (const bf16*)(ws + WS_MK); const bf16* MV = (const bf16*)(ws + WS_MV);
    bf16* MO = (bf16*)(ws + WS_MO); const bf16* KVC = (const bf16*)(ws + WS_XB); const float* NC = (const float*)(ws + WS_NC); const float* MP = (const float*)(ws + WS_SC) + 2048;
    const float* cw = A->conv_w + (size_t)layer * 4096; const float* cb = A->conv_b + (size_t)layer * 1024; const float* nw = A->mlstm_norm_w + layer * 512;
    LAS float* U = (LAS float*)(L + S4_G); LAS float* MROW = U + 64; LAS float* WINT = U + 128; LAS float* ENEG = U + 192; LAS float* DEN = U + 256;
    const int per = (1024 + G - 1) / G; const int u0 = vcu * per, u1 = (u0 + per) < 1024 ? (u0 + per) : 1024;
    const int g = lane >> 4, q = (lane & 15) >> 2, p = lane & 3, fr = lane & 15;
    const int lt = wave & 3, vh = wave >> 2;
    for (int u = u0; u < u1; ++u) {
        const int bh = u >> 6, c = u & 63, b = bh >> 2, h = bh & 3; const size_t rowb = (size_t)b * SEQ_; const int t0 = c * 64;
        __syncthreads();
        if (wave == 0) {
            const float ig = gates[(rowb + t0 + lane) * 8 + h], fg = gates[(rowb + t0 + lane) * 8 + 4 + h]; const float mp = MP[u];
            float bc = logsigmoidf_(fg);
#pragma unroll
            for (int o = 1; o < 64; o <<= 1) { const float t = __shfl_up(bc, o); if (lane >= o) bc += t; }
            const float uu = ig - bc; float pm = uu;
#pragma unroll
            for (int o = 1; o < 64; o <<= 1) { const float t = __shfl_up(pm, o); if (lane >= o) pm = fmaxf(pm, t); }
            const float M = fmaxf(pm, mp);
            U[lane] = uu; MROW[lane] = M; WINT[lane] = __expf(mp - M); ENEG[lane] = __expf(-(bc + M));
        }
#pragma unroll
        for (int i = 0; i < 2; ++i) { const int idx = tid + 512 * i, l = idx >> 4, ch = idx & 15; float o[8];
            conv_silu8(MQ, rowb, t0 + l, h * 128 + ch * 8, cw, cb, h * 128 + ch * 8, o);
            const float sc = 0.08838834764831845f; v4u w; w.x = cvt_pk_bf16(o[0] * sc, o[1] * sc); w.y = cvt_pk_bf16(o[2] * sc, o[3] * sc); w.z = cvt_pk_bf16(o[4] * sc, o[5] * sc); w.w = cvt_pk_bf16(o[6] * sc, o[7] * sc);
            *(LAS v4u*)(L + S4_Q + l * 272 + ch * 16) = w;
            conv_silu8(MK, rowb, t0 + l, h * 128 + ch * 8, cw, cb, 512 + h * 128 + ch * 8, o);
            w.x = cvt_pk_bf16(o[0], o[1]); w.y = cvt_pk_bf16(o[2], o[3]); w.z = cvt_pk_bf16(o[4], o[5]); w.w = cvt_pk_bf16(o[6], o[7]);
            *(LAS v4u*)(L + S4_K + l * 272 + ch * 16) = w;
            *(LAS v4u*)(L + S4_V + l * 288 + ch * 16) = *(const v4u*)(MV + (rowb + t0 + l) * 512 + h * 128 + ch * 8); }
        if (tid < 128) { const int l = tid >> 1, ch = 16 + (tid & 1); *(LAS v4u*)(L + S4_V + l * 288 + ch * 16) = (v4u){(tid & 1) ? 0u : 0x3F80u, 0u, 0u, 0u}; }
#pragma unroll
        for (int i = 0; i < 4; ++i) { const int idx = tid + 512 * i, v = idx >> 4, ch = idx & 15;
            *(LAS v4u*)(L + S4_C + v * 272 + ch * 16) = *(const v4u*)(KVC + ((size_t)u * 128 + v) * 128 + ch * 8); }
        if (tid < 256) { const int v = 128 + (tid >> 4), ch = tid & 15; v4u w = (v4u){0u, 0u, 0u, 0u};
            if (v == 128) { const float* np = NC + (size_t)u * 128 + ch * 8; const f32x4 a = *(const f32x4*)np, bq = *(const f32x4*)(np + 4); w.x = cvt_pk_bf16(a[0], a[1]); w.y = cvt_pk_bf16(a[2], a[3]); w.z = cvt_pk_bf16(bq[0], bq[1]); w.w = cvt_pk_bf16(bq[2], bq[3]); }
            *(LAS v4u*)(L + S4_C + v * 272 + ch * 16) = w; }
        __syncthreads();
        bf16x8 qf[4];
#pragma unroll
        for (int ks = 0; ks < 4; ++ks) qf[ks] = *(const LAS bf16x8*)(L + S4_Q + (16 * lt + fr) * 272 + (32 * ks + 8 * g) * 2);
        const int lrow = 16 * lt + fr; const float Ml = MROW[lrow];
        bf16x8 pa[2];
#pragma unroll
        for (int sp = 0; sp < 2; ++sp) { unsigned pw[4];
#pragma unroll
            for (int hh = 0; hh < 2; ++hh) { const int st = 2 * sp + hh; f32x4 s = (f32x4){0.f, 0.f, 0.f, 0.f};
#pragma unroll
                for (int ks = 0; ks < 4; ++ks) { const bf16x8 kf = *(const LAS bf16x8*)(L + S4_K + (16 * st + fr) * 272 + (32 * ks + 8 * g) * 2); s = mfma16(kf, qf[ks], s); }
                float pv[4];
#pragma unroll
                for (int e = 0; e < 4; ++e) { const int sidx = 16 * st + 4 * g + e; pv[e] = (sidx <= lrow) ? s[e] * __expf(U[sidx] - Ml) : 0.f; }
                pw[2 * hh] = cvt_pk_bf16(pv[0], pv[1]); pw[2 * hh + 1] = cvt_pk_bf16(pv[2], pv[3]); }
            pa[sp] = __builtin_bit_cast(bf16x8, (v4u){pw[0], pw[1], pw[2], pw[3]}); }
        f32x4 acc[5]; const int vt0 = vh ? 5 : 0; const int nvt = vh ? 4 : 5;
#pragma unroll
        for (int i = 0; i < 5; ++i) { acc[i] = (f32x4){0.f, 0.f, 0.f, 0.f};
            if (i < nvt) { const int vt = vt0 + i;
#pragma unroll
                for (int ks = 0; ks < 4; ++ks) { const bf16x8 cf = *(const LAS bf16x8*)(L + S4_C + (16 * vt + fr) * 272 + (32 * ks + 8 * g) * 2); acc[i] = mfma16(qf[ks], cf, acc[i]); }
#pragma unroll
                for (int e = 0; e < 4; ++e) acc[i][e] *= WINT[16 * lt + 4 * g + e];
#pragma unroll
                for (int sp = 0; sp < 2; ++sp) { const bf16x8 vf = cat8(tr16(L + S4_V + (32 * sp + 4 * g + q) * 288 + (16 * vt + 4 * p) * 2), tr16(L + S4_V + (32 * sp + 16 + 4 * g + q) * 288 + (16 * vt + 4 * p) * 2));
                    acc[i] = mfma16(pa[sp], vf, acc[i]); } } }
        if (vh == 1 && fr == 0) {
#pragma unroll
            for (int e = 0; e < 4; ++e) DEN[16 * lt + 4 * g + e] = acc[3][e]; }
        __syncthreads();
#pragma unroll
        for (int i = 0; i < 5; ++i) { if (i < nvt && (vt0 + i) < 8) { const int vt = vt0 + i;
#pragma unroll
                for (int e = 0; e < 4; ++e) { const int l = 16 * lt + 4 * g + e; const float dn = fmaxf(fabsf(DEN[l]), ENEG[l]); *(LAS float*)(L + S4_H + l * 528 + (16 * vt + fr) * 4) = acc[i][e] * __builtin_amdgcn_rcpf(dn); } } }
        __syncthreads();
#pragma unroll
        for (int r = 0; r < 8; ++r) { const int l = 8 * wave + r; const f32x2 hv = *(const LAS f32x2*)(L + S4_H + l * 528 + lane * 8);
            const float ssq = wave_sum(hv[0] * hv[0] + hv[1] * hv[1]); const float rr = rsqrtf(ssq * (1.0f / 128.0f) + 1e-6f);
            unsigned* mp = (unsigned*)(MO + (rowb + t0 + l) * 512 + h * 128 + 2 * lane); const unsigned mo = *mp; const f32x2 nv = *(const f32x2*)(nw + h * 128 + 2 * lane);
            const unsigned yv = cvt_pk_bf16(sigmoidf_(bflo(mo)) * hv[0] * rr * nv[0], sigmoidf_(bfhi(mo)) * hv[1] * rr * nv[1]); if (do_store) *mp = yv; }
    }
}

constexpr int SA_K = 0, SA_V = 36864;
__device__ __forceinline__ void attn_phase(KArgs A, LAS unsigned char* L, int vcu_, int G) {
    PHASE_IDS();
    unsigned char* ws = A->ws;
    const bf16* AQ = (const bf16*)(ws + WS_AQ); const bf16* AK = (const bf16*)(ws + WS_AK); const bf16* AV = (const bf16*)(ws + WS_AV);
    bf16* OG = (bf16*)(ws + WS_OG); float* LSE = (float*)(ws + WS_LSE);
    const int per = (3072 + G - 1) / G; const int u0 = vcu * per, u1 = (u0 + per) < 3072 ? (u0 + per) : 3072;
    const int g = lane >> 4, fr = lane & 15, q4 = (lane & 15) >> 2, p = lane & 3;
    for (int u = u0; u < u1; ++u) {
        const int gp = u >> 10, b = (u >> 8) & 3, h = (u >> 5) & 7, idx = u & 31;
        const int dsh = 2 * gp, d = 1 << dsh, nbs = 5 - dsh;
        const int r = idx >> nbs, blk = idx & ((1 << nbs) - 1);
        const size_t rowb = (size_t)b * SEQ_;
        __syncthreads();
#pragma unroll
        for (int i = 0; i < 4; ++i) { const int id2 = tid + 512 * i, kc = id2 >> 3, ch = id2 & 7; int m = 128 * (blk - 1) + kc; m = m < 0 ? 0 : m;
            const size_t off = (rowb + (size_t)m * d + r) * 512 + h * 64 + ch * 8;
            *(LAS v4u*)(L + SA_K + kc * 144 + ch * 16) = *(const v4u*)(AK + off);
            *(LAS v4u*)(L + SA_V + kc * 144 + ch * 16) = *(const v4u*)(AV + off); }
        const size_t qrow = rowb + (size_t)(128 * blk + 16 * wave + fr) * d + r;
        const bf16x8 qf0 = *(const bf16x8*)(AQ + qrow * 512 + h * 64 + 8 * g), qf1 = *(const bf16x8*)(AQ + qrow * 512 + h * 64 + 32 + 8 * g);
        __syncthreads();
        f32x4 s[9]; float mx = -INFINITY;
#pragma unroll
        for (int jt = 0; jt < 9; ++jt) { const LAS unsigned char* kp = L + SA_K + (16 * wave + 16 * jt + fr) * 144 + 16 * g;
            const bf16x8 k0 = *(const LAS bf16x8*)kp, k1 = *(const LAS bf16x8*)(kp + 64);
            f32x4 a = (f32x4){0.f, 0.f, 0.f, 0.f}; a = mfma16(k0, qf0, a); a = mfma16(k1, qf1, a);
#pragma unroll
            for (int e = 0; e < 4; ++e) { const int rel = 16 * jt + 4 * g + e - fr; const int kc = 16 * wave + 16 * jt + 4 * g + e;
                const bool ok = (rel >= 0) && (rel <= 128) && (blk > 0 || kc >= 128);
                a[e] = ok ? a[e] : -INFINITY; mx = fmaxf(mx, a[e]); }
            s[jt] = a; }
        mx = fmaxf(mx, __shfl_xor(mx, 16)); mx = fmaxf(mx, __shfl_xor(mx, 32));
        float lsum = 0.f;
#pragma unroll
        for (int jt = 0; jt < 9; ++jt)
#pragma unroll
            for (int e = 0; e < 4; ++e) { const float pe = __builtin_amdgcn_exp2f(s[jt][e] - mx); s[jt][e] = pe; lsum += pe; }
        lsum += __shfl_xor(lsum, 16); lsum += __shfl_xor(lsum, 32);
        f32x4 o[4];
#pragma unroll
        for (int dt = 0; dt < 4; ++dt) o[dt] = (f32x4){0.f, 0.f, 0.f, 0.f};
#pragma unroll
        for (int st = 0; st < 5; ++st) { const int t0 = 2 * st, t1 = (2 * st + 1) < 9 ? (2 * st + 1) : 8;
            v4u pw; pw.x = cvt_pk_bf16(s[t0][0], s[t0][1]); pw.y = cvt_pk_bf16(s[t0][2], s[t0][3]);
            if (st < 4) { pw.z = cvt_pk_bf16(s[t1][0], s[t1][1]); pw.w = cvt_pk_bf16(s[t1][2], s[t1][3]); } else { pw.z = 0u; pw.w = 0u; }
            const bf16x8 pa = __builtin_bit_cast(bf16x8, pw);
#pragma unroll
            for (int dt = 0; dt < 4; ++dt) { const s16x4 v0 = tr16(L + SA_V + (16 * wave + 16 * t0 + 4 * g + q4) * 144 + (16 * dt + 4 * p) * 2);
                const s16x4 v1 = (st < 4) ? tr16(L + SA_V + (16 * wave + 16 * t1 + 4 * g + q4) * 144 + (16 * dt + 4 * p) * 2) : v0;
                o[dt] = mfma16(pa, cat8(v0, v1), o[dt]); } }
        const float lse = mx + __builtin_amdgcn_logf(lsum);
        const float inv = __builtin_amdgcn_rcpf(lsum);
        float invq[4];
#pragma unroll
        for (int e = 0; e < 4; ++e) invq[e] = __shfl(inv, 4 * g + e);
        if (g == 0) LSE[((size_t)gp * T_ + qrow) * 8 + h] = lse;
#pragma unroll
        for (int e = 0; e < 4; ++e) { const size_t orow = rowb + (size_t)(128 * blk + 16 * wave + 4 * g + e) * d + r;
#pragma unroll
            for (int dt = 0; dt < 4; ++dt) OG[((size_t)gp * T_ + orow) * 512 + h * 64 + 16 * dt + fr] = (bf16)(cvt_pk_bf16(o[dt][e] * invq[e], 0.f) & 0xffffu); }
    }
}
__device__ __forceinline__ void combine_phase(KArgs A, int vcu_, int G) {
    PHASE_IDS();
    unsigned char* ws = A->ws; const bf16* OG = (const bf16*)(ws + WS_OG); const float* LSE = (const float*)(ws + WS_LSE); bf16* YA = (bf16*)(ws + WS_YA);
    for (int i = vcu * 512 + tid; i < T_ * 64; i += G * 512) { const int tk = i >> 6, ch = i & 63, h = ch >> 3;
        const float l0 = LSE[((size_t)0 * T_ + tk) * 8 + h], l1 = LSE[((size_t)1 * T_ + tk) * 8 + h], l2 = LSE[((size_t)2 * T_ + tk) * 8 + h];
        const float mm = fmaxf(l0, fmaxf(l1, l2)); float w0 = __builtin_amdgcn_exp2f(l0 - mm), w1 = __builtin_amdgcn_exp2f(l1 - mm), w2 = __builtin_amdgcn_exp2f(l2 - mm); const float iw = __builtin_amdgcn_rcpf(w0 + w1 + w2); w0 *= iw; w1 *= iw; w2 *= iw;
        const v4u a = *(const v4u*)(OG + ((size_t)0 * T_ + tk) * 512 + ch * 8), bq = *(const v4u*)(OG + ((size_t)1 * T_ + tk) * 512 + ch * 8), c = *(const v4u*)(OG + ((size_t)2 * T_ + tk) * 512 + ch * 8);
        v4u o;
        o.x = cvt_pk_bf16(w0 * bflo(a.x) + w1 * bflo(bq.x) + w2 * bflo(c.x), w0 * bfhi(a.x) + w1 * bfhi(bq.x) + w2 * bfhi(c.x));
        o.y = cvt_pk_bf16(w0 * bflo(a.y) + w1 * bflo(bq.y) + w2 * bflo(c.y), w0 * bfhi(a.y) + w1 * bfhi(bq.y) + w2 * bfhi(c.y));
        o.z = cvt_pk_bf16(w0 * bflo(a.z) + w1 * bflo(bq.z) + w2 * bflo(c.z), w0 * bfhi(a.z) + w1 * bfhi(bq.z) + w2 * bfhi(c.z));
        o.w = cvt_pk_bf16(w0 * bflo(a.w) + w1 * bflo(bq.w) + w2 * bflo(c.w), w0 * bfhi(a.w) + w1 * bfhi(bq.w) + w2 * bfhi(c.w));
        *(v4u*)(YA + (size_t)tk * 512 + ch * 8) = o; }
}
__device__ __forceinline__ void final_norm_phase(KArgs A, int vcu_, int G) {
    PHASE_IDS();
    const float* ss = (const float*)(A->ws + WS_SS1); const int gw = vcu * NWAVES + wave, NGW = G * NWAVES;
    for (int m = gw; m < T_; m += NGW) { const f32x4 pp = *(const f32x4*)(ss + (size_t)m * 4); const float rs = rsqrtf(((pp[0] + pp[1]) + (pp[2] + pp[3])) * (1.0f / 1024.0f) + 1e-6f);
        f32x4* xr = (f32x4*)(A->out + (size_t)m * DM_) + lane; const f32x4* wr_ = (const f32x4*)A->final_norm_w + lane;
#pragma unroll
        for (int j = 0; j < 4; ++j) xr[64 * j] = xr[64 * j] * rs * wr_[64 * j]; }
}

#ifndef PROBE_DUP
#define PROBE_DUP 0
#endif
__global__ void __launch_bounds__(NWAVES * 64, 2) fwd_megakernel(Args args_by_value) {
    extern __shared__ __attribute__((aligned(16))) unsigned char lds[];
    LAS unsigned char* L = (LAS unsigned char*)lds;
    volatile LAS unsigned* MISC = (volatile LAS unsigned*)(L + MISC_OFF);
    const int tid = threadIdx.x, lane = tid & 63, wave = __builtin_amdgcn_readfirstlane(tid >> 6);
    const int G = gridDim.x, bx = blockIdx.x; const int vcu = (G % 8 == 0) ? (bx % 8) * (G / 8) + bx / 8 : bx;
    gu32* ctl = (gu32*)(kargs()->ws + WS_CTL);
    for (int u = tid; u < (LDS_BYTES - LDSCTL_OFF) / 4; u += NWAVES * 64) ((LAS unsigned*)(L + LDSCTL_OFF))[u] = 0u;
    __syncthreads();
    XcdBarrier bar = xcd_barrier_post((unsigned*)(ctl + CW_BAR), MISC + 8);
#define GRID_BAR() xcd_barrier(bar)
#pragma unroll 1
    for (int layer = 0; layer < 2; ++layer) {
        p0_weights(kargs(), layer, L, vcu, G);
        if (PROBE_DUP & 1) { __syncthreads(); p0_weights(kargs(), layer, L, vcu, G); }
        if (layer == 0) p0_xprep(kargs(), vcu, G);
        GRID_BAR();
        { KArgs A = kargs(); unsigned char* ws = A->ws; pg8::bf16_t* XB = (pg8::bf16_t*)(ws + WS_XB); float* SS1 = (float*)(ws + WS_SS1); float* SS2 = (float*)(ws + WS_SS2); (void)XB; (void)SS1; (void)SS2;
          pg8::Gemm g{XB, (const pg8::bf16_t*)(ws + WS_WIN), T_, NINP_, DM_}; pg8::StaticOrder S; S.init(T_, NINP_, G, bx);
          pg8::EpiInProj E{(pg8::bf16_t*)(ws + WS_Z), (float*)(ws + WS_GATES), SS1, (const float*)(ws + WS_BIAS), (const float*)(ws + WS_ROPE), 1};
          pg8::gemm_phase<pg8::EpiInProj, pg8::StaticOrder, true, true>(L, g, S, E);
          if (PROBE_DUP & 2) { GRID_BAR(); pg8::gemm_phase<pg8::EpiInProj, pg8::StaticOrder, true, true>(L, g, S, E); }
          if (PROBE_DUP & 2048) { GRID_BAR(); pg8::EpiInProj E2 = E; E2.st = (G == 12345); pg8::gemm_phase<pg8::EpiInProj, pg8::StaticOrder, true, true>(L, g, S, E2); }
          if (PROBE_DUP & 1024) { GRID_BAR(); pg8::EpiNull EN{A->out, G == 12345}; pg8::gemm_phase<pg8::EpiNull, pg8::StaticOrder, true, true>(L, g, S, EN); } }
        GRID_BAR();
        mlstm_summary_phase(kargs(), layer, L, vcu, G);
        if (PROBE_DUP & 4) { GRID_BAR(); mlstm_summary_phase(kargs(), layer, L, vcu, G); }
        GRID_BAR();
        mlstm_scan_phase(kargs(), vcu, G);
        GRID_BAR();
        if (PROBE_DUP & 32) { mlstm_output_phase(kargs(), layer, L, vcu, G, G == 12345); GRID_BAR(); }
        mlstm_output_phase(kargs(), layer, L, vcu, G);
        GRID_BAR();
        attn_phase(kargs(), L, vcu, G);
        if (PROBE_DUP & 8) { GRID_BAR(); attn_phase(kargs(), L, vcu, G); }
        if (PROBE_DUP & 64) { for (int i = 0; i < 10; ++i) GRID_BAR(); }
        GRID_BAR();
        combine_phase(kargs(), vcu, G);
        if (PROBE_DUP & 16) { GRID_BAR(); combine_phase(kargs(), vcu, G); }
        GRID_BAR();
        { KArgs A = kargs(); unsigned char* ws = A->ws; pg8::bf16_t* XB = (pg8::bf16_t*)(ws + WS_XB); float* SS1 = (float*)(ws + WS_SS1); float* SS2 = (float*)(ws + WS_SS2); (void)XB; (void)SS1; (void)SS2;
          pg8::Gemm g{(const pg8::bf16_t*)(ws + WS_YA), (const pg8::bf16_t*)(ws + WS_PA), T_, DM_, 512}; pg8::StaticOrder S; S.init(T_, DM_, G, bx);
          pg8::EpiX1 E{(pg8::bf16_t*)(ws + WS_SGA)};
          pg8::gemm_phase<pg8::EpiX1, pg8::StaticOrder, true, true>(L, g, S, E); }
        VM_WAIT(); __syncthreads(); __builtin_amdgcn_fence(__ATOMIC_ACQUIRE, "agent"); VM_WAIT(); __syncthreads();
        { KArgs A = kargs(); unsigned char* ws = A->ws; pg8::bf16_t* XB = (pg8::bf16_t*)(ws + WS_XB); float* SS1 = (float*)(ws + WS_SS1); float* SS2 = (float*)(ws + WS_SS2); (void)XB; (void)SS1; (void)SS2;
          pg8::Gemm g{(const pg8::bf16_t*)(ws + WS_YB), (const pg8::bf16_t*)(ws + WS_PB), T_, DM_, 512}; pg8::StaticOrder S; S.init(T_, DM_, G, bx);
          pg8::EpiX2 E{(pg8::bf16_t*)(ws + WS_SGA), (const pg8::bf16_t*)(ws + WS_SGB)};
          pg8::gemm_phase<pg8::EpiX2, pg8::StaticOrder, true, true>(L, g, S, E); }
        GRID_BAR();
        { KArgs A = kargs(); unsigned char* ws = A->ws; pg8::bf16_t* XB = (pg8::bf16_t*)(ws + WS_XB); float* SS1 = (float*)(ws + WS_SS1); float* SS2 = (float*)(ws + WS_SS2); (void)XB; (void)SS1; (void)SS2;
          pg8::Gemm g{(const pg8::bf16_t*)(ws + WS_SGA), (const pg8::bf16_t*)(ws + WS_WOUT), T_, DM_, DM_}; pg8::StaticOrder S; S.init(T_, DM_, G, bx);
          pg8::EpiResid E{layer == 0 ? A->x : A->out, A->out, XB, SS2};
          pg8::gemm_phase<pg8::EpiResid, pg8::StaticOrder, false, true>(L, g, S, E); }
        GRID_BAR();
        { KArgs A = kargs(); unsigned char* ws = A->ws; pg8::bf16_t* XB = (pg8::bf16_t*)(ws + WS_XB); float* SS1 = (float*)(ws + WS_SS1); float* SS2 = (float*)(ws + WS_SS2); (void)XB; (void)SS1; (void)SS2;
          pg8::Gemm g{XB, (const pg8::bf16_t*)(ws + WS_W1), T_, FF_, DM_}; pg8::StaticOrder S; S.init(T_, FF_, G, bx);
          pg8::EpiFF1 E{(pg8::bf16_t*)(ws + WS_H), SS2, 0};
          pg8::gemm_phase<pg8::EpiFF1, pg8::StaticOrder, true, true>(L, g, S, E);
          if (PROBE_DUP & 4096) { GRID_BAR(); pg8::EpiFF1 E2 = E; E2.mode = (G == 12345) ? 0 : 1; E2.H = (pg8::bf16_t*)(ws + WS_H) + (G == 12345 ? 0 : 0); pg8::gemm_phase<pg8::EpiFF1, pg8::StaticOrder, true, true>(L, g, S, E2); GRID_BAR(); pg8::gemm_phase<pg8::EpiFF1, pg8::StaticOrder, true, true>(L, g, S, E); }
          if (PROBE_DUP & 8192) { GRID_BAR(); pg8::EpiFF1 E2 = E; E2.mode = (G == 12345) ? 0 : 2; pg8::gemm_phase<pg8::EpiFF1, pg8::StaticOrder, true, true>(L, g, S, E2); }
          if (PROBE_DUP & 128) { GRID_BAR(); pg8::gemm_phase<pg8::EpiFF1, pg8::StaticOrder, true, true>(L, g, S, E); } }
        GRID_BAR();
        { KArgs A = kargs(); unsigned char* ws = A->ws; pg8::bf16_t* XB = (pg8::bf16_t*)(ws + WS_XB); float* SS1 = (float*)(ws + WS_SS1); float* SS2 = (float*)(ws + WS_SS2); (void)XB; (void)SS1; (void)SS2;
          pg8::Gemm g{(const pg8::bf16_t*)(ws + WS_H), (const pg8::bf16_t*)(ws + WS_W2), T_, DM_, FF_}; pg8::StaticOrder S; S.init(T_, DM_, G, bx);
          pg8::EpiResid E{A->out, A->out, XB, SS1};
          if (PROBE_DUP & 256) { pg8::EpiNull EN{A->out, G == 12345}; pg8::gemm_phase<pg8::EpiNull, pg8::StaticOrder, true, true>(L, g, S, EN); GRID_BAR(); }
          if (PROBE_DUP & 512) { pg8::Gemm g2{XB, (const pg8::bf16_t*)(ws + WS_WOUT), T_, DM_, DM_}; pg8::EpiNull EN{A->out, G == 12345}; pg8::gemm_phase<pg8::EpiNull, pg8::StaticOrder, true, true>(L, g2, S, EN); GRID_BAR(); }
          pg8::gemm_phase<pg8::EpiResid, pg8::StaticOrder, false, true>(L, g, S, E); }
        GRID_BAR();
    }
    final_norm_phase(kargs(), vcu, G);
}

extern "C" void kernel_launch(void* const* d_in, const int* in_sizes, int n_in, void* d_out, int out_size, void* d_ws, size_t ws_size, hipStream_t stream) {
    static int grid = 0;
    if (grid == 0) {
        int dev = 0, cus = 0;
        if (n_in != 15 || out_size != T_ * DM_ || ws_size < WS_END) { fprintf(stderr, "kernel_launch: unexpected shapes (n_in %d, out %d, ws %zu)\n", n_in, out_size, ws_size); grid = -1; return; }
        if (hipGetDevice(&dev) != hipSuccess || hipDeviceGetAttribute(&cus, hipDeviceAttributeMultiprocessorCount, dev) != hipSuccess) { grid = -1; return; }
        if (hipFuncSetAttribute((const void*)fwd_megakernel, hipFuncAttributeMaxDynamicSharedMemorySize, LDS_BYTES) != hipSuccess) { grid = -1; return; }
        grid = cus;
    }
    if (grid < 0) return;
    (void)hipMemsetAsync((char*)d_ws + WS_CTL, 0, CTL_ZERO_BYTES, stream);
    Args a{};
    a.x = (const float*)d_in[0]; a.pos = (const int*)d_in[1]; a.norm_mix_w = (const float*)d_in[2]; a.w_in = (const float*)d_in[3]; a.b_in = (const float*)d_in[4];
    a.conv_w = (const float*)d_in[5]; a.conv_b = (const float*)d_in[6]; a.mlstm_norm_w = (const float*)d_in[7]; a.w_proj_att = (const float*)d_in[8]; a.w_proj_mlstm = (const float*)d_in[9];
    a.w_out = (const float*)d_in[10]; a.norm_mlp_w = (const float*)d_in[11]; a.w_ff1 = (const float*)d_in[12]; a.w_ff2 = (const float*)d_in[13]; a.final_norm_w = (const float*)d_in[14];
    a.out = (float*)d_out; a.ws = (unsigned char*)d_ws;
    hipLaunchKernelGGL(fwd_megakernel, dim3(grid), dim3(NWAVES * 64), LDS_BYTES, stream, a);
}
```

```cpp
#include <hip/hip_runtime.h>
#include <cstdio>
#include <cstdint>
constexpr int T_ = 16384, DM_ = 1024, SEQ_ = 4096, NINP_ = 5888, FF_ = 4096;
namespace pg8 {
#define PG8_LAS __attribute__((address_space(3)))
typedef unsigned short bf16_t;
typedef short bf16x8 __attribute__((ext_vector_type(8)));
typedef float f32x4 __attribute__((ext_vector_type(4)));
typedef unsigned u32x4 __attribute__((ext_vector_type(4)));
constexpr int BM = 256, BK = 64, HALF = 128, HTB = HALF * BK * 2  , STAGE_BYTES = 8 * HTB, NXCD = 8, WGM = 8;

__host__ __device__ __forceinline__ int lds_byte(int r, int c) { const int st = (r >> 4) * 2 + (c >> 5), rr = r & 15, cc = c & 31, ob = rr * 64 + cc * 2; return st * 1024 + (ob ^ (((ob >> 9) & 1) << 5)); }
__host__ __device__ __forceinline__ void stage_rc(int b, int& R, int& C) { const int st = b / 1024, sb = b % 1024, swz = sb ^ (((sb >> 9) & 1) << 5); R = (st >> 1) * 16 + swz / 64; C = (st & 1) * 32 + (swz % 64) / 2; }
__host__ __device__ __forceinline__ int perm32(int rho) { const int n = rho >> 4, i = rho & 15; return 8 * (i >> 2) + 4 * n + (i & 3); }

struct Unit { int pm, pn; };
struct Gemm { const bf16_t* A; const bf16_t* Bt; int M, N, K; };

struct StaticOrder {
    int nM, nN, nwg, G, c;
    __host__ __device__ void init(int M, int N, int G_, int c_) { nM = M / BM; nN = N / BM; nwg = nM * nN; G = G_; c = c_; }
    __host__ __device__ bool next(int i, Unit& u) const {
        const long L = (long)i * G + c; if (L >= nwg) return false;
        int wgid = (int)L; { const int q = nwg / NXCD, r = nwg % NXCD, xcd = wgid % NXCD, off = wgid / NXCD; wgid = (xcd < r ? xcd * (q + 1) : r * (q + 1) + (xcd - r) * q) + off; }
        const int nig = WGM * nN, gid = wgid / nig, fm = gid * WGM, gsz = (nM - fm) < WGM ? (nM - fm) : WGM;
        u.pm = fm + ((wgid % nig) % gsz); u.pn = (wgid % nig) / gsz; return true;
    }
    __device__ __forceinline__ void a_ready(const Unit&) const {}
    __device__ __forceinline__ void done(const Unit&) const {}
};

typedef float f32x2 __attribute__((ext_vector_type(2)));
typedef __bf16 bf16x2v __attribute__((ext_vector_type(2)));
__device__ __forceinline__ unsigned cvt_pk_bf16(float lo, float hi) { f32x2 v = {lo, hi}; bf16x2v b = __builtin_convertvector(v, bf16x2v); return __builtin_bit_cast(unsigned, b); }
__device__ __forceinline__ float bflo(unsigned w) { return __uint_as_float(w << 16); }
__device__ __forceinline__ float bfhi(unsigned w) { return __uint_as_float(w & 0xffff0000u); }
__device__ __forceinline__ u32x4 pack8(const f32x4 a, const f32x4 b) { u32x4 w; w.x = cvt_pk_bf16(a[0], a[1]); w.y = cvt_pk_bf16(a[2], a[3]); w.z = cvt_pk_bf16(b[0], b[1]); w.w = cvt_pk_bf16(b[2], b[3]); return w; }
__device__ __forceinline__ float shflx_(float v, int lane, int m) { return __int_as_float(__builtin_amdgcn_ds_bpermute((lane ^ m) << 2, __float_as_int(v))); }
__device__ __forceinline__ float sigmoidf_(float x) { return __builtin_amdgcn_rcpf(1.0f + __builtin_amdgcn_exp2f(x * -1.4426950408889634f)); }


#define EPI_FENCE() asm volatile("" ::: "memory")
__device__ __forceinline__ float rstd_of(const f32x4 p) { return rsqrtf(((p[0] + p[1]) + (p[2] + p[3])) * (1.0f / 1024.0f) + 1e-6f); }

struct EpiInProj {
    static constexpr bool PERM = true, AFTER_DRAIN = false;
    bf16_t* zbase; float* gates; const float* ss; const float* bias; const float* rope; int st;
    __device__ __forceinline__ void operator()(const f32x4 (&acc)[2][2][4][2], const Unit& u, int wr, int wc, int fr, int fq) const {
        const int pn = u.pn; const int row0 = u.pm * BM + wr * 64 + fr; const int bcol0 = pn * BM + wc * 32 + 8 * fq;
        f32x4 bv[2][2], pp[2][4];
#pragma unroll
        for (int bj = 0; bj < 2; ++bj)
#pragma unroll
            for (int n = 0; n < 2; ++n) bv[bj][n] = *(const f32x4*)(bias + bcol0 + bj * HALF + 4 * n);
#pragma unroll
        for (int ai = 0; ai < 2; ++ai)
#pragma unroll
            for (int m = 0; m < 4; ++m) pp[ai][m] = *(const f32x4*)(ss + (size_t)(row0 + ai * HALF + m * 16) * 4);
        float rs[2][4];
#pragma unroll
        for (int ai = 0; ai < 2; ++ai)
#pragma unroll
            for (int m = 0; m < 4; ++m) rs[ai][m] = rstd_of(pp[ai][m]);
        if (pn < 14) {
            const int sec = pn >> 1; bf16_t* base = zbase + (size_t)sec * ((size_t)T_ * 512); const int col0 = (pn & 1) * 256 + wc * 32 + 8 * fq;
            const bool isq = pn < 2, rp = pn < 4; const bool rlane = ((wc & 1) == 0) && (fq < 2); const float sgn = (fq == 0) ? -1.f : 1.f;
#pragma unroll
            for (int am = 0; am < 4; ++am) { const int ai = am >> 1, mh = am & 1;
                f32x4 cs[2][4];
                if (rp) {
#pragma unroll
                    for (int m2 = 0; m2 < 2; ++m2) { const float* rr = rope + (size_t)(row0 + ai * HALF + (2 * mh + m2) * 16) * 16;
#pragma unroll
                        for (int k = 0; k < 4; ++k) cs[m2][k] = *(const f32x4*)(rr + 4 * k); }
                    EPI_FENCE();
                }
#pragma unroll
                for (int m2 = 0; m2 < 2; ++m2) { const int m = 2 * mh + m2; const int row = row0 + ai * HALF + m * 16;
#pragma unroll
                    for (int bj = 0; bj < 2; ++bj) { f32x4 v0 = acc[ai][bj][m][0] * rs[ai][m] + bv[bj][0], v1 = acc[ai][bj][m][1] * rs[ai][m] + bv[bj][1];
                        if (rp) { f32x4 q0, q1;
#pragma unroll
                            for (int i = 0; i < 4; ++i) { q0[i] = shflx_(v0[i], fq * 16 + fr, 16); q1[i] = shflx_(v1[i], fq * 16 + fr, 16); }
                            if (rlane) { v0 = v0 * cs[m2][0] + (q0 * cs[m2][2]) * sgn; v1 = v1 * cs[m2][1] + (q1 * cs[m2][3]) * sgn; }
                            if (isq) { v0 = v0 * 0.18033688011112042f; v1 = v1 * 0.18033688011112042f; } }
                        { const u32x4 pk_ = pack8(v0, v1); if (st) *(u32x4*)(base + (size_t)row * 512 + col0 + bj * HALF) = pk_; else asm volatile("" :: "v"(pk_)); } } }
                if (rp) EPI_FENCE();
            }
        } else if (pn < 22) {
            const int q = pn - 14; bf16_t* base = zbase + (size_t)7 * ((size_t)T_ * 512) + (size_t)(q >> 2) * ((size_t)T_ * 1024); const int col0 = (q & 3) * 256 + wc * 32 + 8 * fq;
#pragma unroll
            for (int ai = 0; ai < 2; ++ai)
#pragma unroll
                for (int m = 0; m < 4; ++m) { const int row = row0 + ai * HALF + m * 16;
#pragma unroll
                    for (int bj = 0; bj < 2; ++bj) { f32x4 v0 = acc[ai][bj][m][0] * rs[ai][m] + bv[bj][0], v1 = acc[ai][bj][m][1] * rs[ai][m] + bv[bj][1];
#pragma unroll
                        for (int i = 0; i < 4; ++i) { v0[i] = sigmoidf_(v0[i]); v1[i] = sigmoidf_(v1[i]); }
                        { const u32x4 pk_ = pack8(v0, v1); if (st) *(u32x4*)(base + (size_t)row * 1024 + col0 + bj * HALF) = pk_; else asm volatile("" :: "v"(pk_)); } } }
        } else {
            if (wc == 0 && fq == 0) {
#pragma unroll
                for (int ai = 0; ai < 2; ++ai)
#pragma unroll
                    for (int m = 0; m < 4; ++m) { const int row = row0 + ai * HALF + m * 16;
                        *(f32x4*)(gates + (size_t)row * 8) = acc[ai][0][m][0] * rs[ai][m] + bv[0][0]; *(f32x4*)(gates + (size_t)row * 8 + 4) = acc[ai][0][m][1] * rs[ai][m] + bv[0][1]; }
            }
        }
    }
};
struct EpiFF1 {
    static constexpr bool PERM = true, AFTER_DRAIN = false;
    bf16_t* H; const float* ss; int mode;
    __device__ __forceinline__ void operator()(const f32x4 (&acc)[2][2][4][2], const Unit& u, int wr, int wc, int fr, int fq) const {
        const int row0 = u.pm * BM + wr * 64 + fr, col0 = u.pn * BM + wc * 32 + 8 * fq;
        f32x4 pp[2][4];
#pragma unroll
        for (int ai = 0; ai < 2; ++ai)
#pragma unroll
            for (int m = 0; m < 4; ++m) pp[ai][m] = (mode == 1) ? (f32x4){1024.f, 0.f, 0.f, 0.f} : *(const f32x4*)(ss + (size_t)(row0 + ai * HALF + m * 16) * 4);
        EPI_FENCE();
#pragma unroll
        for (int ai = 0; ai < 2; ++ai)
#pragma unroll
            for (int m = 0; m < 4; ++m) { const int row = row0 + ai * HALF + m * 16; const float rs = rstd_of(pp[ai][m]);
#pragma unroll
                for (int bj = 0; bj < 2; ++bj) { f32x4 v0 = acc[ai][bj][m][0] * rs, v1 = acc[ai][bj][m][1] * rs;
#pragma unroll
                    for (int i = 0; i < 4; ++i) { const float a = fmaxf(v0[i], 0.f), b = fmaxf(v1[i], 0.f); v0[i] = a * a; v1[i] = b * b; }
                    { const u32x4 pk_ = pack8(v0, v1); if (mode != 2) *(u32x4*)(H + (size_t)row * FF_ + col0 + bj * HALF) = pk_; else asm volatile("" :: "v"(pk_)); } } }
    }
};
struct EpiX1 {
    static constexpr bool PERM = true, AFTER_DRAIN = false;
    bf16_t* G;
    __device__ __forceinline__ void operator()(const f32x4 (&acc)[2][2][4][2], const Unit& u, int wr, int wc, int fr, int fq) const {
        const int row0 = u.pm * BM + wr * 64 + fr, col0 = u.pn * BM + wc * 32 + 8 * fq;
        u32x4 gv[2][4][2];
#pragma unroll
        for (int ai = 0; ai < 2; ++ai)
#pragma unroll
            for (int m = 0; m < 4; ++m)
#pragma unroll
                for (int bj = 0; bj < 2; ++bj) gv[ai][m][bj] = *(const u32x4*)(G + (size_t)(row0 + ai * HALF + m * 16) * 1024 + col0 + bj * HALF);
        EPI_FENCE();
#pragma unroll
        for (int ai = 0; ai < 2; ++ai)
#pragma unroll
            for (int m = 0; m < 4; ++m) { const int row = row0 + ai * HALF + m * 16;
#pragma unroll
                for (int bj = 0; bj < 2; ++bj) { const u32x4 g = gv[ai][m][bj];
                    const f32x4 a0 = acc[ai][bj][m][0], a1 = acc[ai][bj][m][1];
                    f32x4 v0 = {bflo(g.x) * a0[0], bfhi(g.x) * a0[1], bflo(g.y) * a0[2], bfhi(g.y) * a0[3]}, v1 = {bflo(g.z) * a1[0], bfhi(g.z) * a1[1], bflo(g.w) * a1[2], bfhi(g.w) * a1[3]};
                    *(u32x4*)(G + (size_t)row * 1024 + col0 + bj * HALF) = pack8(v0, v1); } }
    }
};
struct EpiX2 {
    static constexpr bool PERM = true, AFTER_DRAIN = false;
    bf16_t* MIX; const bf16_t* GB;
    __device__ __forceinline__ void operator()(const f32x4 (&acc)[2][2][4][2], const Unit& u, int wr, int wc, int fr, int fq) const {
        const int row0 = u.pm * BM + wr * 64 + fr, col0 = u.pn * BM + wc * 32 + 8 * fq;
#pragma unroll
        for (int ai = 0; ai < 2; ++ai) {
            u32x4 tv[4][2], gv[4][2];
#pragma unroll
            for (int m = 0; m < 4; ++m)
#pragma unroll
                for (int bj = 0; bj < 2; ++bj) { const size_t off = (size_t)(row0 + ai * HALF + m * 16) * 1024 + col0 + bj * HALF; tv[m][bj] = *(const u32x4*)(MIX + off); gv[m][bj] = *(const u32x4*)(GB + off); }
            EPI_FENCE();
#pragma unroll
            for (int m = 0; m < 4; ++m)
#pragma unroll
                for (int bj = 0; bj < 2; ++bj) { const size_t off = (size_t)(row0 + ai * HALF + m * 16) * 1024 + col0 + bj * HALF; const u32x4 t = tv[m][bj], g = gv[m][bj];
                    const f32x4 a0 = acc[ai][bj][m][0], a1 = acc[ai][bj][m][1];
                    f32x4 v0 = {bflo(t.x) + bflo(g.x) * a0[0], bfhi(t.x) + bfhi(g.x) * a0[1], bflo(t.y) + bflo(g.y) * a0[2], bfhi(t.y) + bfhi(g.y) * a0[3]};
                    f32x4 v1 = {bflo(t.z) + bflo(g.z) * a1[0], bfhi(t.z) + bfhi(g.z) * a1[1], bflo(t.w) + bflo(g.w) * a1[2], bfhi(t.w) + bfhi(g.w) * a1[3]};
                    *(u32x4*)(MIX + off) = pack8(v0, v1); }
            EPI_FENCE();
        }
    }
};
struct EpiResid {
    static constexpr bool PERM = true, AFTER_DRAIN = true;
    const float* base; float* out; bf16_t* xb; float* ss;
    __device__ __forceinline__ void fused(f32x4 (&acc)[2][2][4][2], const Unit& u, int wr, int wc, int fr, int fq, PG8_LAS unsigned char* lds, int wid, int lane) const {
        PG8_LAS float* P = (PG8_LAS float*)lds;
        const int row0 = u.pm * BM + wr * 64 + fr, col0 = u.pn * BM + wc * 32 + 8 * fq;
#pragma unroll
        for (int ai = 0; ai < 2; ++ai)
#pragma unroll
            for (int mh = 0; mh < 2; ++mh) {
                f32x4 b0[2][2], b1[2][2];
#pragma unroll
                for (int m2 = 0; m2 < 2; ++m2)
#pragma unroll
                    for (int bj = 0; bj < 2; ++bj) { const size_t off = (size_t)(row0 + ai * HALF + (2 * mh + m2) * 16) * 1024 + col0 + bj * HALF; b0[m2][bj] = *(const f32x4*)(base + off); b1[m2][bj] = *(const f32x4*)(base + off + 4); }
                EPI_FENCE();
#pragma unroll
                for (int m2 = 0; m2 < 2; ++m2) { const int m = 2 * mh + m2; const int row = row0 + ai * HALF + m * 16; float sq = 0.f;
#pragma unroll
                    for (int bj = 0; bj < 2; ++bj) { const size_t off = (size_t)row * 1024 + col0 + bj * HALF;
                        const f32x4 v0 = acc[ai][bj][m][0] + b0[m2][bj], v1 = acc[ai][bj][m][1] + b1[m2][bj];
                        *(f32x4*)(out + off) = v0; *(f32x4*)(out + off + 4) = v1; *(u32x4*)(xb + off) = pack8(v0, v1);
                        sq += (v0[0] * v0[0] + v0[1] * v0[1]) + (v0[2] * v0[2] + v0[3] * v0[3]) + (v1[0] * v1[0] + v1[1] * v1[1]) + (v1[2] * v1[2] + v1[3] * v1[3]); }
                    sq += shflx_(sq, lane, 16); sq += shflx_(sq, lane, 32);
                    if (fq == 0) P[(ai * HALF + wr * 64 + m * 16 + fr) * 4 + wc] = sq; }
                EPI_FENCE();
            }
        asm volatile("s_waitcnt lgkmcnt(0)" ::: "memory"); __builtin_amdgcn_s_barrier(); asm volatile("" ::: "memory");
        const int t = wid * 64 + lane;
        if (t < 256) { const float s = (P[t * 4 + 0] + P[t * 4 + 1]) + (P[t * 4 + 2] + P[t * 4 + 3]); ss[(size_t)(u.pm * BM + t) * 4 + u.pn] = s; }
        asm volatile("s_waitcnt lgkmcnt(0)" ::: "memory"); __builtin_amdgcn_s_barrier(); asm volatile("" ::: "memory");
    }
};

struct EpiNull {
    static constexpr bool PERM = true, AFTER_DRAIN = false;
    float* sink; int flag;
    __device__ __forceinline__ void operator()(const f32x4 (&acc)[2][2][4][2], const Unit& u, int wr, int wc, int fr, int fq) const {
        if (flag) {
#pragma unroll
            for (int ai = 0; ai < 2; ++ai)
#pragma unroll
                for (int m = 0; m < 4; ++m)
#pragma unroll
                    for (int bj = 0; bj < 2; ++bj) { *(f32x4*)(sink + (size_t)(u.pm * 256 + wr * 64 + fr + ai * 128 + m * 16) * 1024 + u.pn * 256 + wc * 32 + 8 * fq + bj * 128) = acc[ai][bj][m][0] + acc[ai][bj][m][1]; }
        }
    }
};

template <class Epi, class Sched, bool ALIGN_EPI = false, bool SP2 = false>
__device__ __forceinline__ void gemm_phase(PG8_LAS unsigned char* lds, const Gemm g, const Sched& S, const Epi& E, int wave_sgpr) {
    int wv_s_ = wave_sgpr; asm volatile("" : "+s"(wv_s_)); unsigned zz_ = 0u; asm volatile("" : "+s"(zz_)); int tid_l = wv_s_ * 64 + (int)__builtin_amdgcn_mbcnt_hi(~0u, __builtin_amdgcn_mbcnt_lo(~0u, zz_)); asm volatile("" : "+v"(tid_l));
    const int tid = tid_l, wid = __builtin_amdgcn_readfirstlane(tid >> 6), lane = tid & 63, wr = wid >> 2, wc = wid & 3, fr = lane & 15, fq = lane >> 4;
    const int K = g.K, nt = K / BK;
    unsigned voffA[2], voffB[2];
#pragma unroll
    for (int i = 0; i < 2; ++i) { int R, C; stage_rc(tid * 16 + i * 8192, R, C); const int Rb = Epi::PERM ? ((R & ~31) + perm32(R & 31)) : R;
        voffA[i] = (unsigned)(R * K + C) * 2u; voffB[i] = (unsigned)(Rb * K + C) * 2u; }
    const size_t kstep = (size_t)(BK * 2);
    const size_t hstep = (size_t)HALF * K * 2;
    const size_t tstep = 2 * hstep;
    const unsigned ldsw = (unsigned)wid * 1024u;
    const int aoff = lds_byte(wr * 64 + fr, fq * 8), boff = lds_byte(wc * 32 + fr, fq * 8);
#define PG8_SA(b, h) (((b) * 2 + (h)) * HTB)
#define PG8_SB(b, h) ((4 + (b) * 2 + (h)) * HTB)
#define PG8_STAGE(bufoff, gbase, voff) do { _Pragma("unroll") for (int _i = 0; _i < 2; ++_i) \
        __builtin_amdgcn_global_load_lds((const unsigned*)((const char*)(gbase) + (voff)[_i]), (PG8_LAS unsigned*)(lds + (bufoff) + ldsw + _i * 8192), 16, 0, 0); } while (0)
#define PG8_LDA(dst, b, h) do { _Pragma("unroll") for (int m = 0; m < 4; ++m) _Pragma("unroll") for (int k = 0; k < 2; ++k) dst[m][k] = *(const PG8_LAS bf16x8*)(lds + PG8_SA(b, h) + aoff + m * 2048 + k * 1024); } while (0)
#define PG8_LDB(dst, b, h) do { _Pragma("unroll") for (int n = 0; n < 2; ++n) _Pragma("unroll") for (int k = 0; k < 2; ++k) dst[n][k] = *(const PG8_LAS bf16x8*)(lds + PG8_SB(b, h) + boff + n * 2048 + k * 1024); } while (0)
#define PG8_MMA(ai, bj, At, Bt) do { __builtin_amdgcn_s_setprio(1); _Pragma("unroll") for (int m = 0; m < 4; ++m) _Pragma("unroll") for (int n = 0; n < 2; ++n) _Pragma("unroll") for (int k = 0; k < 2; ++k) \
        acc[ai][bj][m][n] = __builtin_amdgcn_mfma_f32_16x16x32_bf16(Bt[n][k], At[m][k], acc[ai][bj][m][n], 0, 0, 0); __builtin_amdgcn_s_setprio(0); } while (0)
#define PG8_WAIT_V(n) asm volatile("s_waitcnt vmcnt(" #n ")" ::: "memory")
#define PG8_WAIT_L(n) asm volatile("s_waitcnt lgkmcnt(" #n ")" ::: "memory")
#define PG8_BAR __builtin_amdgcn_s_barrier()
#define PG8_SCHED __builtin_amdgcn_sched_barrier(0)
    Unit cur, nxt; int ui = 0;
    if (!S.next(0, cur)) return;
    f32x4 acc[2][2][4][2];
#pragma unroll
    for (int a = 0; a < 2; ++a)
#pragma unroll
        for (int b = 0; b < 2; ++b)
#pragma unroll
            for (int m = 0; m < 4; ++m)
#pragma unroll
                for (int n = 0; n < 2; ++n) acc[a][b][m][n] = (f32x4){0.f, 0.f, 0.f, 0.f};
    bf16x8 At[4][2], B0[2][2], B1[2][2];
    const char* cA = (const char*)g.A + (size_t)cur.pm * tstep; const char* cB = (const char*)g.Bt + (size_t)cur.pn * tstep;
    S.a_ready(cur);
    if constexpr (SP2) {
        PG8_STAGE(PG8_SB(0, 0), cB, voffB); PG8_STAGE(PG8_SB(0, 1), cB + hstep, voffB); PG8_STAGE(PG8_SA(0, 0), cA, voffA); PG8_STAGE(PG8_SA(0, 1), cA + hstep, voffA);
        if (wr == 1) PG8_BAR;
        PG8_WAIT_V(2); PG8_BAR;
        PG8_STAGE(PG8_SB(1, 0), cB + kstep, voffB); PG8_STAGE(PG8_SA(1, 0), cA + kstep, voffA); PG8_STAGE(PG8_SB(1, 1), cB + hstep + kstep, voffB);
        PG8_WAIT_V(6); PG8_BAR;
    } else {
        PG8_STAGE(PG8_SB(0, 0), cB, voffB); PG8_STAGE(PG8_SA(0, 0), cA, voffA); PG8_STAGE(PG8_SB(0, 1), cB + hstep, voffB); PG8_STAGE(PG8_SA(0, 1), cA + hstep, voffA);
        if (wr == 1) PG8_BAR;
        PG8_WAIT_V(4); PG8_BAR;
        PG8_STAGE(PG8_SB(1, 0), cB + kstep, voffB); PG8_STAGE(PG8_SA(1, 0), cA + kstep, voffA); PG8_STAGE(PG8_SB(1, 1), cB + hstep + kstep, voffB);
        PG8_WAIT_V(6); PG8_BAR;
    }
    for (;;) {
        const bool has_next = S.next(ui + 1, nxt);
        const char* nA = has_next ? (const char*)g.A + (size_t)nxt.pm * tstep : cA; const char* nB = has_next ? (const char*)g.Bt + (size_t)nxt.pn * tstep : cB;
        for (int t = 0; t < nt; t += 2) {
            const bool last = (t == nt - 2);
            const char* a1 = cA + (size_t)(t + 1) * kstep;
            const char* a2 = last ? nA : cA + (size_t)(t + 2) * kstep; const char* b2 = last ? nB : cB + (size_t)(t + 2) * kstep;
            const char* a3 = a2 + kstep; const char* b3 = b2 + kstep;
            if (last && has_next) S.a_ready(nxt);
            if constexpr (SP2) {
            PG8_LDB(B0, 0, 0); PG8_LDB(B1, 0, 1); PG8_SCHED; PG8_LDA(At, 0, 0); PG8_STAGE(PG8_SA(1, 1), a1 + hstep, voffA);
            PG8_WAIT_V(8); PG8_WAIT_L(0); PG8_BAR; PG8_MMA(0, 0, At, B0); PG8_MMA(0, 1, At, B1); PG8_BAR; PG8_SCHED;
            PG8_LDA(At, 0, 1); PG8_STAGE(PG8_SB(0, 0), b2, voffB); PG8_STAGE(PG8_SB(0, 1), b2 + hstep, voffB); PG8_STAGE(PG8_SA(0, 0), a2, voffA);
            PG8_WAIT_V(8); PG8_WAIT_L(0); PG8_BAR; PG8_MMA(1, 0, At, B0); PG8_MMA(1, 1, At, B1); PG8_BAR; PG8_SCHED;
            PG8_LDB(B0, 1, 0); PG8_LDB(B1, 1, 1); PG8_SCHED; PG8_LDA(At, 1, 0); PG8_STAGE(PG8_SA(0, 1), a2 + hstep, voffA);
            PG8_WAIT_V(8); PG8_WAIT_L(0); PG8_BAR; PG8_MMA(0, 0, At, B0); PG8_MMA(0, 1, At, B1); PG8_BAR; PG8_SCHED;
            PG8_LDA(At, 1, 1); PG8_STAGE(PG8_SB(1, 0), b3, voffB); PG8_STAGE(PG8_SB(1, 1), b3 + hstep, voffB); PG8_STAGE(PG8_SA(1, 0), a3, voffA);
            PG8_WAIT_V(8); PG8_WAIT_L(0); PG8_BAR; PG8_MMA(1, 0, At, B0); PG8_MMA(1, 1, At, B1); PG8_BAR; PG8_SCHED;
            } else {
            PG8_LDB(B0, 0, 0); PG8_SCHED; PG8_LDA(At, 0, 0); PG8_STAGE(PG8_SA(1, 1), a1 + hstep, voffA);
            PG8_WAIT_L(8); PG8_BAR; PG8_WAIT_L(0); PG8_MMA(0, 0, At, B0); PG8_BAR; PG8_SCHED;
            PG8_LDB(B1, 0, 1); PG8_STAGE(PG8_SB(0, 0), b2, voffB);
            PG8_BAR; PG8_WAIT_L(0); PG8_MMA(0, 1, At, B1); PG8_BAR;
            PG8_LDA(At, 0, 1); PG8_STAGE(PG8_SA(0, 0), a2, voffA);
            PG8_BAR; PG8_WAIT_L(0); PG8_MMA(1, 0, At, B0); PG8_BAR; PG8_SCHED;
            PG8_STAGE(PG8_SB(0, 1), b2 + hstep, voffB);
            PG8_WAIT_V(6); PG8_BAR; PG8_MMA(1, 1, At, B1); PG8_BAR;
            PG8_LDB(B0, 1, 0); PG8_SCHED; PG8_LDA(At, 1, 0); PG8_STAGE(PG8_SA(0, 1), a2 + hstep, voffA);
            PG8_WAIT_L(8); PG8_BAR; PG8_WAIT_L(0); PG8_MMA(0, 0, At, B0); PG8_BAR; PG8_SCHED;
            PG8_LDB(B1, 1, 1); PG8_STAGE(PG8_SB(1, 0), b3, voffB);
            PG8_BAR; PG8_WAIT_L(0); PG8_MMA(0, 1, At, B1); PG8_BAR;
            PG8_LDA(At, 1, 1); PG8_STAGE(PG8_SA(1, 0), a3, voffA);
            PG8_BAR; PG8_WAIT_L(0); PG8_MMA(1, 0, At, B0); PG8_BAR; PG8_SCHED;
            PG8_STAGE(PG8_SB(1, 1), b3 + hstep, voffB);
            PG8_WAIT_V(6); PG8_BAR; PG8_MMA(1, 1, At, B1); PG8_BAR;
            }
        }
        if constexpr (ALIGN_EPI) { if (wr == 0) PG8_BAR; }
        if constexpr (!Epi::AFTER_DRAIN) { E(acc, cur, wr, wc, fr, fq); S.done(cur); }
        if (!has_next) break;
#pragma unroll
        for (int a = 0; a < 2; ++a)
#pragma unroll
            for (int b = 0; b < 2; ++b)
#pragma unroll
                for (int m = 0; m < 4; ++m)
#pragma unroll
                    for (int n = 0; n < 2; ++n) acc[a][b][m][n] = (f32x4){0.f, 0.f, 0.f, 0.f};
        cur = nxt; cA = nA; cB = nB; ++ui;
        if constexpr (ALIGN_EPI) { if (wr == 1) PG8_BAR; }
    }
    PG8_WAIT_V(0);
    if constexpr (!ALIGN_EPI) { if (wr == 0) PG8_BAR; }
    PG8_BAR;
    if constexpr (Epi::AFTER_DRAIN) { E.fused(acc, cur, wr, wc, fr, fq, lds, wid, lane); S.done(cur); }
#undef PG8_SA
#undef PG8_SB
#undef PG8_STAGE
#undef PG8_LDA
#undef PG8_LDB
#undef PG8_MMA
#undef PG8_WAIT_V
#undef PG8_WAIT_L
#undef PG8_BAR
#undef PG8_SCHED
}
}
constexpr int NWAVES = 8;
constexpr size_t MiB = 1u << 20;
constexpr size_t WS_CTL = 0, CTL_ZERO_BYTES = 1 * MiB;
constexpr size_t WS_ROPE = 1 * MiB;
constexpr size_t WS_GATES = 2 * MiB;
constexpr size_t WS_SS1 = 3 * MiB;
constexpr size_t WS_SS2 = 4 * MiB;
constexpr size_t WS_LSE = 5 * MiB;
constexpr size_t WS_NC = 6 * MiB + 512 * 1024;
constexpr size_t WS_SC = 7 * MiB;
constexpr size_t WS_BIAS = 7 * MiB + 256 * 1024;
constexpr size_t WS_WIN = 8 * MiB;
constexpr size_t WS_PA = WS_WIN + (size_t)NINP_ * 1024 * 2;
constexpr size_t WS_PB = WS_PA + 1 * MiB;
constexpr size_t WS_WOUT = WS_PB + 1 * MiB;
constexpr size_t WS_W1 = WS_WOUT + 2 * MiB;
constexpr size_t WS_W2 = WS_W1 + 8 * MiB;
constexpr size_t WS_XB = 40 * MiB;
constexpr size_t WS_Z = 72 * MiB;
constexpr size_t SEC = 16 * MiB;
constexpr size_t WS_AQ = WS_Z, WS_AK = WS_Z + SEC, WS_AV = WS_Z + 2 * SEC, WS_MQ = WS_Z + 3 * SEC, WS_MK = WS_Z + 4 * SEC, WS_MV = WS_Z + 5 * SEC, WS_MO = WS_Z + 6 * SEC, WS_SGA = WS_Z + 7 * SEC, WS_SGB = WS_Z + 9 * SEC;
constexpr size_t WS_OG = WS_MQ;
constexpr size_t WS_YA = WS_AQ;
constexpr size_t WS_YB = WS_MO;
constexpr size_t WS_H = WS_Z;
constexpr size_t WS_END = WS_Z + 11 * SEC;
static_assert(WS_W2 + 8 * MiB <= WS_XB && WS_END <= 256 * MiB, "d_ws map");
constexpr int CW_TMO = 0, CW_CODE = 1;
constexpr int CW_BAR = 4096;
constexpr int RING_BYTES = 131072;
constexpr int LDSCTL_OFF = RING_BYTES, MISC_OFF = LDSCTL_OFF + 320;
constexpr int LDS_BYTES = 147456;
#define GAS __attribute__((address_space(1)))
#define LAS __attribute__((address_space(3)))
typedef unsigned short bf16;
typedef unsigned v4u __attribute__((ext_vector_type(4)));
typedef float f32x4 __attribute__((ext_vector_type(4)));
typedef short bf16x8 __attribute__((ext_vector_type(8)));
typedef GAS unsigned gu32;
typedef GAS unsigned long long gu64;
#define RLX_AGENT __ATOMIC_RELAXED, __HIP_MEMORY_SCOPE_AGENT
#define LDS_WAIT() asm volatile("s_waitcnt lgkmcnt(0)" ::: "memory")
#define VM_WAIT() asm volatile("s_waitcnt vmcnt(0)" ::: "memory")
__device__ __forceinline__ unsigned long long rt() { return __builtin_amdgcn_s_memrealtime(); }
__device__ __forceinline__ unsigned f2bf(float f) { unsigned u = __builtin_bit_cast(unsigned, f); return (u + 0x7fffu + ((u >> 16) & 1u)) >> 16; }
__device__ __forceinline__ unsigned pk2(float lo, float hi) { return f2bf(lo) | (f2bf(hi) << 16); }

#define XB_TMO      128
#define XB_XCNT(j)  (256  + 64 * (j))
#define XB_XSUB(j)  (1280 + 64 * (j))
#define XB_XGEN(j)  (2304 + 64 * (j))
#define XB_TOP      3328
#define XB_TOPGEN   3392
#define XCD_BAR_WORDS 3456
#define XB_SPIN_CAP (1u << 18)

__device__ __forceinline__ unsigned xb_ld(unsigned* p)              { return __hip_atomic_load(p, __ATOMIC_RELAXED, __HIP_MEMORY_SCOPE_AGENT); }
__device__ __forceinline__ unsigned xb_add(unsigned* p, unsigned v) { return __hip_atomic_fetch_add(p, v, __ATOMIC_RELAXED, __HIP_MEMORY_SCOPE_AGENT); }
__device__ __forceinline__ unsigned xb_xcc_id() { return (unsigned)__builtin_amdgcn_s_getreg((3 << 11) | 20) & 0xFu; }
#define XB_SPIN(cond, bar) do { unsigned _sp = 0; while (cond) { __builtin_amdgcn_s_sleep(1); \
    if ((++_sp & 255u) == 0u) { if (xb_ld(&(bar)[XB_TMO])) break; if (_sp > XB_SPIN_CAP) { atomicAdd(&(bar)[XB_TMO], 1u); break; } } } } while (0)

struct XcdBarrier {
    unsigned* bar; unsigned x; int wave;
    volatile LAS unsigned* st;
};

__device__ __forceinline__ bool xb_thread0(int wave) { unsigned zz_ = 0u; asm volatile("" : "+s"(zz_)); return wave == 0 && __builtin_amdgcn_mbcnt_hi(~0u, __builtin_amdgcn_mbcnt_lo(~0u, zz_)) == 0u; }
__device__ __forceinline__ XcdBarrier xcd_barrier_post(unsigned* bar, volatile LAS unsigned* st, int wave) {
    XcdBarrier b; b.bar = bar; b.x = xb_xcc_id(); b.st = st; b.wave = wave;
    if (xb_thread0(wave)) (void)xb_add(&bar[XB_XCNT(b.x)], 1u);
    return b;
}
__device__ __forceinline__ void xcd_barrier_complete(unsigned* bar, unsigned x, unsigned& nloc, unsigned& nx) {
    const unsigned G = gridDim.x * gridDim.y * gridDim.z;
    unsigned sum, cnt, mine, sp = 0u;
    for (;;) {
        sum = 0u; cnt = 0u; mine = 0u;
#pragma unroll
        for (unsigned j = 0; j < 16; ++j) { const unsigned c = xb_ld(&bar[XB_XCNT(j)]); sum += c; cnt += (c > 0u) ? 1u : 0u; mine = (j == x) ? c : mine; }
        if (sum == G) break;
        __builtin_amdgcn_s_sleep(1);
        if ((++sp & 255u) == 0u) { if (xb_ld(&bar[XB_TMO])) break; if (sp > XB_SPIN_CAP) { atomicAdd(&bar[XB_TMO], 1u); break; } }
    }
    nloc = mine > 0u ? mine : 1u; nx = cnt > 0u ? cnt : 1u;
}

__device__ __forceinline__ void xcd_barrier(const XcdBarrier& b) {
    asm volatile("s_waitcnt vmcnt(0)" ::: "memory");
    __syncthreads();
    if (xb_thread0(b.wave)) {
        unsigned* bar = b.bar;
        __builtin_amdgcn_s_waitcnt(0);
        unsigned nloc = b.st[0], nx = b.st[1];
        if (nloc == 0u) { xcd_barrier_complete(bar, b.x, nloc, nx); b.st[0] = nloc; b.st[1] = nx; }
        const unsigned old = xb_add(&bar[XB_XSUB(b.x)], 1u);
        const unsigned gen = old / nloc;
        if (old + 1u == (gen + 1u) * nloc) {
            __builtin_amdgcn_fence(__ATOMIC_RELEASE, "agent");
            asm volatile("s_waitcnt vmcnt(0)" ::: "memory");
            const unsigned og = xb_add(&bar[XB_TOP], 1u);
            const unsigned tg = og / nx;
            if (og + 1u == (tg + 1u) * nx) xb_add(&bar[XB_TOPGEN], 1u);
            else XB_SPIN(xb_ld(&bar[XB_TOPGEN]) == tg, bar);
            __builtin_amdgcn_fence(__ATOMIC_ACQUIRE, "agent");
            xb_add(&bar[XB_XGEN(b.x)], 1u);
            asm volatile("s_waitcnt vmcnt(0)" ::: "memory");
        } else {
            XB_SPIN(xb_ld(&bar[XB_XGEN(b.x)]) == gen, bar);
            __builtin_amdgcn_fence(__ATOMIC_ACQUIRE, "agent");
            asm volatile("s_waitcnt vmcnt(0)" ::: "memory");
        }
    }
    __syncthreads();
}

typedef short s16x4 __attribute__((ext_vector_type(4)));
typedef float f32x2 __attribute__((ext_vector_type(2)));
typedef unsigned u32x2 __attribute__((ext_vector_type(2)));
using pg8::cvt_pk_bf16; using pg8::bflo; using pg8::bfhi; using pg8::sigmoidf_;
__device__ __forceinline__ s16x4 tr16(const LAS unsigned char* p) { return __builtin_bit_cast(s16x4, __builtin_amdgcn_ds_read_tr16_b64_v4i16((LAS s16x4*)p)); }
__device__ __forceinline__ bf16x8 cat8(s16x4 a, s16x4 b) { return (bf16x8){a[0], a[1], a[2], a[3], b[0], b[1], b[2], b[3]}; }
__device__ __forceinline__ f32x4 mfma16(bf16x8 a, bf16x8 b, f32x4 c) { return __builtin_amdgcn_mfma_f32_16x16x32_bf16(a, b, c, 0, 0, 0); }
__device__ __forceinline__ float shfl_idx(float v, int srclane) { return __int_as_float(__builtin_amdgcn_ds_bpermute(srclane << 2, __float_as_int(v))); }
__device__ __forceinline__ float wave_sum(float v, int lane) {
#pragma unroll
    for (int o = 1; o < 64; o <<= 1) v += shfl_idx(v, lane ^ o);
    return v;
}
__device__ __forceinline__ float wave_max(float v, int lane) {
#pragma unroll
    for (int o = 1; o < 64; o <<= 1) v = fmaxf(v, shfl_idx(v, lane ^ o));
    return v;
}

#define PHASE_IDS() int wv_s_ = wave_sgpr; asm volatile("" : "+s"(wv_s_)); unsigned zz_ = 0u; asm volatile("" : "+s"(zz_)); int tid = wv_s_ * 64 + (int)__builtin_amdgcn_mbcnt_hi(~0u, __builtin_amdgcn_mbcnt_lo(~0u, zz_)); asm volatile("" : "+v"(tid)); int vcu = vcu_; asm volatile("" : "+s"(vcu)); const int lane = tid & 63, wave = wv_s_; float zf_ = 0.f; asm volatile("" : "+v"(zf_)); const f32x4 ZERO4 = (f32x4){zf_, zf_, zf_, zf_}; (void)ZERO4; (void)lane; (void)wave; (void)vcu
struct Args {
    const float *x; const int* pos; const float *norm_mix_w, *w_in, *b_in, *conv_w, *conv_b, *mlstm_norm_w, *w_proj_att, *w_proj_mlstm, *w_out, *norm_mlp_w, *w_ff1, *w_ff2, *final_norm_w;
    float* out; unsigned char* ws;
};

typedef const __attribute__((address_space(4))) Args* KArgs;
__device__ __forceinline__ KArgs kargs() { KArgs p = (KArgs)__builtin_amdgcn_kernarg_segment_ptr(); asm volatile("" : "+s"(p)); return p; }

__device__ __forceinline__ int inproj_src_col(int n) { return n < 3584 ? n : (n < 5632 ? n + 8 : (n < 5640 ? n - 5632 + 3584 : -1)); }
template <bool REMAP>
__device__ __forceinline__ void transpose_item(const float* W, int K, int Nsrc, bf16* WT, int Ndst, const float* kscale, LAS float* scr, int item, int lane) {
    const int nblk = Ndst / 32, kb = item / nblk, nb = item % nblk, k0 = 64 * kb, n0 = 32 * nb;
    const int n_ = n0 + (lane & 31); const int sc = REMAP ? inproj_src_col(n_) : n_;
    float wv[32];
#pragma unroll
    for (int i = 0; i < 32; ++i) { const int kk = 2 * i + (lane >> 5); wv[i] = (sc >= 0) ? W[(size_t)(k0 + kk) * Nsrc + sc] : 0.f; }
    if (kscale) {
#pragma unroll
        for (int i = 0; i < 32; ++i) wv[i] *= kscale[k0 + 2 * i + (lane >> 5)]; }
#pragma unroll
    for (int i = 0; i < 32; ++i) { const int kk = 2 * i + (lane >> 5); scr[kk * 33 + (lane & 31)] = wv[i]; }
    LDS_WAIT(); asm volatile("" ::: "memory");
    const int c = lane & 7;
#pragma unroll
    for (int j = 0; j < 4; ++j) { const int n = (lane >> 3) + 8 * j; const LAS float* s = scr + (8 * c) * 33 + n;
        v4u o; o.x = cvt_pk_bf16(s[0 * 33], s[1 * 33]); o.y = cvt_pk_bf16(s[2 * 33], s[3 * 33]); o.z = cvt_pk_bf16(s[4 * 33], s[5 * 33]); o.w = cvt_pk_bf16(s[6 * 33], s[7 * 33]);
        *(GAS v4u*)(WT + (size_t)(n0 + n) * K + k0 + 8 * c) = o; }
    LDS_WAIT(); asm volatile("" ::: "memory");
}
__device__ __forceinline__ void p0_weights(KArgs A, int layer, LAS unsigned char* L, int vcu_, int G, int wave_sgpr) {
    PHASE_IDS();
    LAS float* scr = (LAS float*)(L + wave * 16384);
    const int gw = vcu * NWAVES + wave, NGW = G * NWAVES;
    constexpr int I_IN = 16 * (NINP_ / 32), I_P = 8 * 32, I_O = 16 * 32, I_1 = 16 * 128, I_2 = 64 * 32;
    constexpr int NITEMS = I_IN + 2 * I_P + I_O + I_1 + I_2;
    unsigned char* ws = A->ws;
    for (int it = gw; it < NITEMS; it += NGW) {
        int r = it;
        if (r < I_IN) { transpose_item<true>(A->w_in + (size_t)layer * 1024 * 5640, 1024, 5640, (bf16*)(ws + WS_WIN), NINP_, A->norm_mix_w + layer * 1024, scr, r, lane); continue; } r -= I_IN;
        if (r < I_P) { transpose_item<false>(A->w_proj_att + (size_t)layer * 512 * 1024, 512, 1024, (bf16*)(ws + WS_PA), 1024, nullptr, scr, r, lane); continue; } r -= I_P;
        if (r < I_P) { transpose_item<false>(A->w_proj_mlstm + (size_t)layer * 512 * 1024, 512, 1024, (bf16*)(ws + WS_PB), 1024, nullptr, scr, r, lane); continue; } r -= I_P;
        if (r < I_O) { transpose_item<false>(A->w_out + (size_t)layer * 1024 * 1024, 1024, 1024, (bf16*)(ws + WS_WOUT), 1024, nullptr, scr, r, lane); continue; } r -= I_O;
        if (r < I_1) { transpose_item<false>(A->w_ff1 + (size_t)layer * 1024 * 4096, 1024, 4096, (bf16*)(ws + WS_W1), 4096, A->norm_mlp_w + layer * 1024, scr, r, lane); continue; } r -= I_1;
        transpose_item<false>(A->w_ff2 + (size_t)layer * 4096 * 1024, 4096, 1024, (bf16*)(ws + WS_W2), 1024, nullptr, scr, r, lane);
    }
    float* bias = (float*)(ws + WS_BIAS);
    for (int n = vcu * 512 + tid; n < NINP_; n += G * 512) { const int sc = inproj_src_col(n); bias[n] = sc >= 0 ? A->b_in[layer * 5640 + sc] : 0.f; }
}
__device__ __forceinline__ void p0_xprep(KArgs A, int vcu_, int G, int wave_sgpr) {
    PHASE_IDS();
    unsigned char* ws = A->ws;
    const int gw = vcu * NWAVES + wave, NGW = G * NWAVES;
    bf16* xb = (bf16*)(ws + WS_XB); float* ss = (float*)(ws + WS_SS1);
    for (int m = gw; m < T_; m += NGW) {
        const GAS f32x4* xr = (const GAS f32x4*)(A->x + (size_t)m * DM_) + lane; f32x4 v[4]; float s = 0.f;
#pragma unroll
        for (int j = 0; j < 4; ++j) { v[j] = xr[64 * j]; s += (v[j][0] * v[j][0] + v[j][1] * v[j][1]) + (v[j][2] * v[j][2] + v[j][3] * v[j][3]); }
        s = wave_sum(s, lane);
        GAS u32x2* o8 = (GAS u32x2*)(xb + (size_t)m * DM_) + lane;
#pragma unroll
        for (int j = 0; j < 4; ++j) { u32x2 w; w.x = cvt_pk_bf16(v[j][0], v[j][1]); w.y = cvt_pk_bf16(v[j][2], v[j][3]); o8[64 * j] = w; }
        if (lane == 0) *(f32x4*)(ss + (size_t)m * 4) = (f32x4){s, 0.f, 0.f, 0.f};
    }
    float* rope = (float*)(ws + WS_ROPE);
    for (int i = vcu * 512 + tid; i < T_ * 8; i += G * 512) { const int tk = i >> 3, j = i & 7;
        double inv = 1.0;
#pragma unroll
        for (int k = 0; k < 7; ++k) inv *= (k < j) ? 0.19392274474868576 : 1.0;
        const double ang = (double)A->pos[tk] * inv; const double nrev = __builtin_rint(ang * 0.15915494309189535); const double r = ang - nrev * 6.283185307179586; const double r2 = r * r;
        double sn = 1.0, cs = 1.0, ts = 1.0, tc = 1.0;
#pragma unroll
        for (int k = 1; k <= 14; ++k) { tc *= -r2 / (double)((2 * k - 1) * (2 * k)); ts *= -r2 / (double)((2 * k) * (2 * k + 1)); cs += tc; sn += ts; }
        rope[tk * 16 + j] = (float)cs; rope[tk * 16 + 8 + j] = (float)(sn * r); }
}

__device__ __forceinline__ void conv_silu8(const bf16* src, size_t rowb, int tt, int col, const float* cw, const float* cb, int ch, float (&o)[8]) {
    const f32x4 b0 = *(const f32x4*)(cb + ch), b1 = *(const f32x4*)(cb + ch + 4);
    float a[8] = {b0[0], b0[1], b0[2], b0[3], b1[0], b1[1], b1[2], b1[3]};
#pragma unroll
    for (int j = 0; j < 4; ++j) { const int t2 = tt - 3 + j;
        if (t2 >= 0) { const v4u xin = *(const v4u*)(src + (rowb + t2) * 512 + col);
            const f32x4 w0 = *(const f32x4*)(cw + j * 1024 + ch), w1 = *(const f32x4*)(cw + j * 1024 + ch + 4);
            a[0] += w0[0] * bflo(xin.x); a[1] += w0[1] * bfhi(xin.x); a[2] += w0[2] * bflo(xin.y); a[3] += w0[3] * bfhi(xin.y);
            a[4] += w1[0] * bflo(xin.z); a[5] += w1[1] * bfhi(xin.z); a[6] += w1[2] * bflo(xin.w); a[7] += w1[3] * bfhi(xin.w); } }
#pragma unroll
    for (int e = 0; e < 8; ++e) o[e] = a[e] * sigmoidf_(a[e]);
}
__device__ __forceinline__ float logsigmoidf_(float x) { return fminf(x, 0.f) - log1pf(__expf(-fabsf(x))); }

__device__ __forceinline__ void conv8_reg(const v4u (&x)[4], int tt, const LAS float* cwl, int c8, float (&o)[8]) {
    const f32x4 b0 = *(const LAS f32x4*)(cwl + 512 + c8), b1 = *(const LAS f32x4*)(cwl + 512 + c8 + 4);
    float a[8] = {b0[0], b0[1], b0[2], b0[3], b1[0], b1[1], b1[2], b1[3]};
#pragma unroll
    for (int j = 0; j < 4; ++j) { const f32x4 w0 = *(const LAS f32x4*)(cwl + j * 128 + c8), w1 = *(const LAS f32x4*)(cwl + j * 128 + c8 + 4); const float ok = (tt - 3 + j >= 0) ? 1.f : 0.f; const v4u xin = x[j];
        a[0] += ok * w0[0] * bflo(xin.x); a[1] += ok * w0[1] * bfhi(xin.x); a[2] += ok * w0[2] * bflo(xin.y); a[3] += ok * w0[3] * bfhi(xin.y);
        a[4] += ok * w1[0] * bflo(xin.z); a[5] += ok * w1[1] * bfhi(xin.z); a[6] += ok * w1[2] * bflo(xin.w); a[7] += ok * w1[3] * bfhi(xin.w); }
#pragma unroll
    for (int e = 0; e < 8; ++e) o[e] = a[e] * sigmoidf_(a[e]);
}
__device__ __forceinline__ void conv_w_to_lds(LAS float* cwl, const float* cw, const float* cb, int cbase, int tid) {
    for (int i = tid; i < 640; i += 512) { const int j = i >> 7, c = i & 127; cwl[i] = (j < 4) ? cw[j * 1024 + cbase + c] : cb[cbase + c]; }
}
constexpr int S2_V = 0, S2_K = 18432, S2_WK = 36864, S2_CW = 37120;
__device__ __forceinline__ void mlstm_summary_phase(KArgs A, int layer, LAS unsigned char* L, int vcu_, int G, int wave_sgpr) {
    PHASE_IDS();
    unsigned char* ws = A->ws;
    const float* gates = (const float*)(ws + WS_GATES); const bf16* MK = (const bf16*)(ws + WS_MK); const bf16* MV = (const bf16*)(ws + WS_MV);
    bf16* KVC = (bf16*)(ws + WS_XB); float* NC = (float*)(ws + WS_NC); float* Gc = (float*)(ws + WS_SC); float* MLc = Gc + 1024;
    const float* cw = A->conv_w + (size_t)layer * 4096; const float* cb = A->conv_b + (size_t)layer * 1024;
    LAS float* WK = (LAS float*)(L + S2_WK); LAS float* CWL = (LAS float*)(L + S2_CW);
    const int per = (1024 + G - 1) / G; const int u0 = vcu * per, u1 = (u0 + per) < 1024 ? (u0 + per) : 1024;
    if (u0 >= u1) return;
    const int g = lane >> 4, q = (lane & 15) >> 2, p = lane & 3;
    const int ch = tid & 15, lr = tid >> 4;
    v4u xk[2][4], vv[2]; float g_ig, g_fg;
#define S2_LOAD(U) do { const int bh_ = (U) >> 6, c_ = (U) & 63, b_ = bh_ >> 2, h_ = bh_ & 3; const size_t rb_ = (size_t)b_ * SEQ_; const int t0_ = c_ * 64; \
        _Pragma("unroll") for (int i_ = 0; i_ < 2; ++i_) { const int l_ = lr + 32 * i_; vv[i_] = *(const v4u*)(MV + (rb_ + t0_ + l_) * 512 + h_ * 128 + ch * 8); \
            _Pragma("unroll") for (int j_ = 0; j_ < 4; ++j_) { int t2_ = t0_ + l_ - 3 + j_; t2_ = t2_ < 0 ? 0 : t2_; xk[i_][j_] = *(const v4u*)(MK + (rb_ + t2_) * 512 + h_ * 128 + ch * 8); } } \
        if (wave == 0) { g_ig = gates[(rb_ + t0_ + lane) * 8 + h_]; g_fg = gates[(rb_ + t0_ + lane) * 8 + 4 + h_]; } } while (0)
    S2_LOAD(u0);
    int hcur = -1;
    for (int u = u0; u < u1; ++u) {
        const int bh = u >> 6, c = u & 63, h = bh & 3; const int t0 = c * 64;
        __syncthreads();
        if (h != hcur) { conv_w_to_lds(CWL, cw, cb, 512 + h * 128, tid); hcur = h; }
        if (wave == 0) {
            float bc = logsigmoidf_(g_fg);
#pragma unroll
            for (int o = 1; o < 64; o <<= 1) { const float t = shfl_idx(bc, lane - o); if (lane >= o) bc += t; }
            const float gt = shfl_idx(bc, 63); const float a = gt - bc + g_ig; const float ml = wave_max(a, lane);
            WK[lane] = __expf(a - ml);
            if (lane == 0) { Gc[u] = gt; MLc[u] = ml; }
        }
        __syncthreads();
#pragma unroll
        for (int i = 0; i < 2; ++i) { const int l = lr + 32 * i;
            *(LAS v4u*)(L + S2_V + l * 288 + ch * 16) = vv[i];
            float o[8]; conv8_reg(xk[i], t0 + l, CWL, ch * 8, o);
            const float w = WK[l]; v4u kw; kw.x = cvt_pk_bf16(o[0] * w, o[1] * w); kw.y = cvt_pk_bf16(o[2] * w, o[3] * w); kw.z = cvt_pk_bf16(o[4] * w, o[5] * w); kw.w = cvt_pk_bf16(o[6] * w, o[7] * w);
            *(LAS v4u*)(L + S2_K + l * 288 + ch * 16) = kw; }
        if (u + 1 < u1) S2_LOAD(u + 1);
        __syncthreads();
        f32x4 acc[9];
#pragma unroll
        for (int i = 0; i < 9; ++i) acc[i] = ZERO4;
        const bf16x8 ones = {0x3F80, 0x3F80, 0x3F80, 0x3F80, 0x3F80, 0x3F80, 0x3F80, 0x3F80};
#pragma unroll
        for (int ls = 0; ls < 2; ++ls) { const int r1 = 32 * ls + 8 * g + q;
            const bf16x8 bfr = cat8(tr16(L + S2_K + r1 * 288 + (16 * wave + 4 * p) * 2), tr16(L + S2_K + (r1 + 4) * 288 + (16 * wave + 4 * p) * 2));
#pragma unroll
            for (int it = 0; it < 8; ++it) { const bf16x8 afr = cat8(tr16(L + S2_V + r1 * 288 + (16 * it + 4 * p) * 2), tr16(L + S2_V + (r1 + 4) * 288 + (16 * it + 4 * p) * 2));
                acc[it] = mfma16(afr, bfr, acc[it]); }
            acc[8] = mfma16(ones, bfr, acc[8]); }
        const int kcol = 16 * wave + (lane & 15);
#pragma unroll
        for (int it = 0; it < 8; ++it)
#pragma unroll
            for (int e = 0; e < 4; ++e) { const int v = 16 * it + 4 * g + e; KVC[((size_t)u * 128 + v) * 128 + kcol] = (bf16)(cvt_pk_bf16(acc[it][e], 0.f) & 0xffffu); }
        if (g == 0) NC[(size_t)u * 128 + kcol] = acc[8][0];
    }
#undef S2_LOAD
}
__device__ __forceinline__ void mlstm_scan_phase(KArgs A, int vcu_, int G, int wave_sgpr) {
    PHASE_IDS();
    unsigned char* ws = A->ws;
    unsigned* KVC = (unsigned*)(ws + WS_XB); float* NC = (float*)(ws + WS_NC); const float* Gc = (const float*)(ws + WS_SC); const float* MLc = Gc + 1024; float* MP = (float*)(ws + WS_SC) + 2048;
    for (int idx = vcu * 512 + tid; idx < 16 * 8192; idx += G * 512) {
        const int bh = idx >> 13, e2 = idx & 8191; unsigned* p = KVC + (size_t)bh * 64 * 8192 + e2; float m = 0.f, C0 = 0.f, C1 = 0.f;
        for (int c0 = 0; c0 < 64; c0 += 16) { unsigned kv[16];
#pragma unroll
            for (int j = 0; j < 16; ++j) kv[j] = p[(size_t)(c0 + j) * 8192];
#pragma unroll
            for (int j = 0; j < 16; ++j) { const int c = c0 + j; const float gg = Gc[bh * 64 + c], ml = MLc[bh * 64 + c];
                p[(size_t)c * 8192] = cvt_pk_bf16(C0, C1); if (e2 == 0) MP[bh * 64 + c] = m;
                const float mn = fmaxf(gg + m, ml), dec = __expf(gg + m - mn), inj = __expf(ml - mn);
                C0 = dec * C0 + inj * bflo(kv[j]); C1 = dec * C1 + inj * bfhi(kv[j]); m = mn; } }
    }
    for (int idx = vcu * 512 + tid; idx < 16 * 128; idx += G * 512) {
        const int bh = idx >> 7, k = idx & 127; float* p = NC + (size_t)bh * 64 * 128 + k; float m = 0.f, n = 0.f;
        for (int c = 0; c < 64; ++c) { const float gg = Gc[bh * 64 + c], ml = MLc[bh * 64 + c]; const float nc = p[c * 128]; p[c * 128] = n;
            const float mn = fmaxf(gg + m, ml), dec = __expf(gg + m - mn), inj = __expf(ml - mn); n = dec * n + inj * nc; m = mn; }
    }
}
constexpr int S4_Q = 0, S4_K = 17408, S4_V = 34816, S4_C = 53248, S4_H = 53248, S4_G = 92416, S4_CW = 94208;
__device__ __forceinline__ void mlstm_output_phase(KArgs A, int layer, LAS unsigned char* L, int vcu_, int G, int wave_sgpr, bool do_store = true) {
    PHASE_IDS();
    unsigned char* ws = A->ws;
    const float* gates = (const float*)(ws + WS_GATES); const bf16* MQ = (const bf16*)(ws + WS_MQ); const bf16* MK = (const bf16*)(ws + WS_MK); const bf16* MV = (const bf16*)(ws + WS_MV);
    bf16* MO = (bf16*)(ws + WS_MO); const bf16* KVC = (const bf16*)(ws + WS_XB); const float* NC = (const float*)(ws + WS_NC); const float* MP = (const float*)(ws + WS_SC) + 2048;
    const float* cw = A->conv_w + (size_t)layer * 4096; const float* cb = A->conv_b + (size_t)layer * 1024; const float* nw = A->mlstm_norm_w + layer * 512;
    LAS float* U = (LAS float*)(L + S4_G); LAS float* MROW = U + 64; LAS float* WINT = U + 128; LAS float* ENEG = U + 192; LAS float* DEN = U + 256; LAS float* CWL = (LAS float*)(L + S4_CW);
    const int per = (1024 + G - 1) / G; const int u0 = vcu * per, u1 = (u0 + per) < 1024 ? (u0 + per) : 1024;
    if (u0 >= u1) return;
    const int g = lane >> 4, q = (lane & 15) >> 2, p = lane & 3, fr = lane & 15;
    const int lt = wave & 3, vh = wave >> 2;
    const int ch = tid & 15, lr = tid >> 4;
    v4u xq[2][4], xk[2][4], vv[2]; float g_ig, g_fg, g_mp;
#define S4_LOAD(U_) do { const int bh_ = (U_) >> 6, c_ = (U_) & 63, b_ = bh_ >> 2, h_ = bh_ & 3; const size_t rb_ = (size_t)b_ * SEQ_; const int t0_ = c_ * 64; \
        _Pragma("unroll") for (int i_ = 0; i_ < 2; ++i_) { const int l_ = lr + 32 * i_; vv[i_] = *(const v4u*)(MV + (rb_ + t0_ + l_) * 512 + h_ * 128 + ch * 8); \
            _Pragma("unroll") for (int j_ = 0; j_ < 4; ++j_) { int t2_ = t0_ + l_ - 3 + j_; t2_ = t2_ < 0 ? 0 : t2_; xq[i_][j_] = *(const v4u*)(MQ + (rb_ + t2_) * 512 + h_ * 128 + ch * 8); xk[i_][j_] = *(const v4u*)(MK + (rb_ + t2_) * 512 + h_ * 128 + ch * 8); } } \
        if (wave == 0) { g_ig = gates[(rb_ + t0_ + lane) * 8 + h_]; g_fg = gates[(rb_ + t0_ + lane) * 8 + 4 + h_]; g_mp = MP[(U_)]; } } while (0)
    S4_LOAD(u0);
    if (tid < 128) { const int l = tid >> 1, c2 = 16 + (tid & 1); *(LAS v4u*)(L + S4_V + l * 288 + c2 * 16) = (v4u){(tid & 1) ? 0u : 0x3F80u, 0u, 0u, 0u}; }
    if (tid < 240) { const int v = 129 + (tid >> 4), c2 = tid & 15; *(LAS f32x4*)(L + S4_C + v * 272 + c2 * 16) = ZERO4; }
    int hcur = -1;
    for (int u = u0; u < u1; ++u) {
        const int bh = u >> 6, c = u & 63, b = bh >> 2, h = bh & 3; const size_t rowb = (size_t)b * SEQ_; const int t0 = c * 64;
        __syncthreads();
        if (h != hcur) { conv_w_to_lds(CWL, cw, cb, h * 128, tid); conv_w_to_lds(CWL + 640, cw, cb, 512 + h * 128, tid); hcur = h; }
        if (wave == 0) {
            float bc = logsigmoidf_(g_fg);
#pragma unroll
            for (int o = 1; o < 64; o <<= 1) { const float t = shfl_idx(bc, lane - o); if (lane >= o) bc += t; }
            const float uu = g_ig - bc; float pm = uu;
#pragma unroll
            for (int o = 1; o < 64; o <<= 1) { const float t = shfl_idx(pm, lane - o); if (lane >= o) pm = fmaxf(pm, t); }
            const float M = fmaxf(pm, g_mp);
            int lo_ = lane * 4; asm volatile("" : "+v"(lo_));
            LAS float* Ug = (LAS float*)(L + S4_G + lo_); Ug[0] = uu; Ug[64] = M; Ug[128] = __expf(g_mp - M); Ug[192] = __expf(-(bc + M));
        }
        v4u cc[4]; f32x4 np0, np1;
#pragma unroll
        for (int i = 0; i < 4; ++i) cc[i] = *(const v4u*)(KVC + ((size_t)u * 128 + lr + 32 * i) * 128 + ch * 8);
        if (tid < 16) { const float* np_ = NC + (size_t)u * 128 + tid * 8; np0 = *(const f32x4*)np_; np1 = *(const f32x4*)(np_ + 4); }
        unsigned mov[8];
#pragma unroll
        for (int r = 0; r < 8; ++r) mov[r] = *(const unsigned*)(MO + (rowb + t0 + 8 * wave + r) * 512 + h * 128 + 2 * lane);
#pragma unroll
        for (int i = 0; i < 2; ++i) *(LAS v4u*)(L + S4_V + (lr + 32 * i) * 288 + ch * 16) = vv[i];
        __syncthreads();
#pragma unroll
        for (int i = 0; i < 2; ++i) { const int l = lr + 32 * i; float o[8];
            conv8_reg(xq[i], t0 + l, CWL, ch * 8, o);
            const float sc = 0.08838834764831845f; v4u w; w.x = cvt_pk_bf16(o[0] * sc, o[1] * sc); w.y = cvt_pk_bf16(o[2] * sc, o[3] * sc); w.z = cvt_pk_bf16(o[4] * sc, o[5] * sc); w.w = cvt_pk_bf16(o[6] * sc, o[7] * sc);
            *(LAS v4u*)(L + S4_Q + l * 272 + ch * 16) = w;
            conv8_reg(xk[i], t0 + l, CWL + 640, ch * 8, o);
            w.x = cvt_pk_bf16(o[0], o[1]); w.y = cvt_pk_bf16(o[2], o[3]); w.z = cvt_pk_bf16(o[4], o[5]); w.w = cvt_pk_bf16(o[6], o[7]);
            *(LAS v4u*)(L + S4_K + l * 272 + ch * 16) = w; }
#pragma unroll
        for (int i = 0; i < 4; ++i) *(LAS v4u*)(L + S4_C + (lr + 32 * i) * 272 + ch * 16) = cc[i];
        if (tid < 16) { v4u w; w.x = cvt_pk_bf16(np0[0], np0[1]); w.y = cvt_pk_bf16(np0[2], np0[3]); w.z = cvt_pk_bf16(np1[0], np1[1]); w.w = cvt_pk_bf16(np1[2], np1[3]); *(LAS v4u*)(L + S4_C + 128 * 272 + tid * 16) = w; }
        if (u + 1 < u1) S4_LOAD(u + 1);
        __syncthreads();
        bf16x8 qf[4];
#pragma unroll
        for (int ks = 0; ks < 4; ++ks) qf[ks] = *(const LAS bf16x8*)(L + S4_Q + (16 * lt + fr) * 272 + (32 * ks + 8 * g) * 2);
        const int lrow = 16 * lt + fr; const float Ml = MROW[lrow];
        bf16x8 pa[2];
#pragma unroll
        for (int sp = 0; sp < 2; ++sp) { unsigned pw[4];
#pragma unroll
            for (int hh = 0; hh < 2; ++hh) { const int st = 2 * sp + hh; f32x4 s = ZERO4;
#pragma unroll
                for (int ks = 0; ks < 4; ++ks) { const bf16x8 kf = *(const LAS bf16x8*)(L + S4_K + (16 * st + fr) * 272 + (32 * ks + 8 * g) * 2); s = mfma16(kf, qf[ks], s); }
                float pv[4];
#pragma unroll
                for (int e = 0; e < 4; ++e) { const int sidx = 16 * st + 4 * g + e; pv[e] = (sidx <= lrow) ? s[e] * __expf(U[sidx] - Ml) : 0.f; }
                pw[2 * hh] = cvt_pk_bf16(pv[0], pv[1]); pw[2 * hh + 1] = cvt_pk_bf16(pv[2], pv[3]); }
            pa[sp] = __builtin_bit_cast(bf16x8, (v4u){pw[0], pw[1], pw[2], pw[3]}); }
        f32x4 acc[5]; const int vt0 = vh ? 5 : 0; const int nvt = vh ? 4 : 5;
#pragma unroll
        for (int i = 0; i < 5; ++i) { acc[i] = ZERO4;
            if (i < nvt) { const int vt = vt0 + i;
#pragma unroll
                for (int ks = 0; ks < 4; ++ks) { const bf16x8 cf = *(const LAS bf16x8*)(L + S4_C + (16 * vt + fr) * 272 + (32 * ks + 8 * g) * 2); acc[i] = mfma16(qf[ks], cf, acc[i]); }
#pragma unroll
                for (int e = 0; e < 4; ++e) acc[i][e] *= WINT[16 * lt + 4 * g + e];
#pragma unroll
                for (int sp = 0; sp < 2; ++sp) { const bf16x8 vf = cat8(tr16(L + S4_V + (32 * sp + 4 * g + q) * 288 + (16 * vt + 4 * p) * 2), tr16(L + S4_V + (32 * sp + 16 + 4 * g + q) * 288 + (16 * vt + 4 * p) * 2));
                    acc[i] = mfma16(pa[sp], vf, acc[i]); } } }
        if (vh == 1 && fr == 0) {
#pragma unroll
            for (int e = 0; e < 4; ++e) DEN[16 * lt + 4 * g + e] = acc[3][e]; }
        __syncthreads();
#pragma unroll
        for (int i = 0; i < 5; ++i) { if (i < nvt && (vt0 + i) < 8) { const int vt = vt0 + i;
#pragma unroll
                for (int e = 0; e < 4; ++e) { const int l = 16 * lt + 4 * g + e; const float dn = fmaxf(fabsf(DEN[l]), ENEG[l]); *(LAS float*)(L + S4_H + l * 528 + (16 * vt + fr) * 4) = acc[i][e] * __builtin_amdgcn_rcpf(dn); } } }
        __syncthreads();
        const f32x2 nv = *(const f32x2*)(nw + h * 128 + 2 * lane);
#pragma unroll
        for (int r = 0; r < 8; ++r) { const int l = 8 * wave + r; const f32x2 hv = *(const LAS f32x2*)(L + S4_H + l * 528 + lane * 8);
            const float ssq = wave_sum(hv[0] * hv[0] + hv[1] * hv[1], lane); const float rr = rsqrtf(ssq * (1.0f / 128.0f) + 1e-6f);
            unsigned* mp = (unsigned*)(MO + (rowb + t0 + l) * 512 + h * 128 + 2 * lane); const unsigned mo = mov[r];
            const unsigned yv = cvt_pk_bf16(sigmoidf_(bflo(mo)) * hv[0] * rr * nv[0], sigmoidf_(bfhi(mo)) * hv[1] * rr * nv[1]); if (do_store) *mp = yv; }
    }
#undef S4_LOAD
}

constexpr int SLOT_B = 36864, SLOT_V = 18432;
struct AttnU { int gp, b, h, r, blk, dsh; };
__device__ __forceinline__ AttnU attn_decode(int u) { AttnU a; a.gp = u >> 10; a.b = (u >> 8) & 3; a.h = (u >> 5) & 7; const int idx = u & 31; a.dsh = 2 * a.gp; const int nbs = 5 - a.dsh; a.r = idx >> nbs; a.blk = idx & ((1 << nbs) - 1); return a; }
__device__ __forceinline__ void attn_phase(KArgs A, LAS unsigned char* L, int vcu_, int G, int wave_sgpr) {
    PHASE_IDS();
    unsigned char* ws = A->ws;
    const bf16* AQ = (const bf16*)(ws + WS_AQ); const bf16* AK = (const bf16*)(ws + WS_AK); const bf16* AV = (const bf16*)(ws + WS_AV);
    bf16* OG = (bf16*)(ws + WS_OG); float* LSE = (float*)(ws + WS_LSE);
    const int per = (3072 + G - 1) / G; const int u0 = vcu * per, u1 = (u0 + per) < 3072 ? (u0 + per) : 3072;
    if (u0 >= u1) return;
    const int g = lane >> 4, fr = lane & 15, q4 = (lane & 15) >> 2, p = lane & 3;
    const int srow0 = tid >> 3, sch = tid & 7;
#define ATT_LOAD_BLOCK(U, BLK, R0, R1, R2, R3) do { const int d_ = 1 << (U).dsh; const size_t rb_ = (size_t)(U).b * SEQ_; \
        const size_t o0_ = (rb_ + (size_t)(128 * (BLK) + srow0) * d_ + (U).r) * 512 + (U).h * 64 + sch * 8, o1_ = o0_ + (size_t)64 * d_ * 512; \
        R0 = *(const v4u*)(AK + o0_); R1 = *(const v4u*)(AK + o1_); R2 = *(const v4u*)(AV + o0_); R3 = *(const v4u*)(AV + o1_); } while (0)
#define ATT_WRITE_BLOCK(SLOT, R0, R1, R2, R3) do { LAS unsigned char* s_ = L + (SLOT) * SLOT_B + srow0 * 144 + sch * 16; \
        *(LAS v4u*)(s_) = R0; *(LAS v4u*)(s_ + 64 * 144) = R1; *(LAS v4u*)(s_ + SLOT_V) = R2; *(LAS v4u*)(s_ + SLOT_V + 64 * 144) = R3; } while (0)
#define ATT_LOAD_Q(U, Q0, Q1) do { const int d_ = 1 << (U).dsh; const size_t qr_ = (size_t)(U).b * SEQ_ + (size_t)(128 * (U).blk + 16 * wave + fr) * d_ + (U).r; \
        Q0 = *(const bf16x8*)(AQ + qr_ * 512 + (U).h * 64 + 8 * g); Q1 = *(const bf16x8*)(AQ + qr_ * 512 + (U).h * 64 + 32 + 8 * g); } while (0)
    AttnU cu = attn_decode(u0);
    bf16x8 qf0, qf1;
    __syncthreads();
    { v4u a0, a1, a2, a3, b0, b1, b2, b3; const int pb = cu.blk > 0 ? cu.blk - 1 : 0;
      ATT_LOAD_BLOCK(cu, pb, a0, a1, a2, a3); ATT_LOAD_BLOCK(cu, cu.blk, b0, b1, b2, b3); ATT_LOAD_Q(cu, qf0, qf1);
      ATT_WRITE_BLOCK(0, a0, a1, a2, a3); ATT_WRITE_BLOCK(1, b0, b1, b2, b3); }
    __syncthreads();
    int sp = 0, sc = 1, sf = 2;
    for (int u = u0; u < u1; ++u) {
        const bool has_next = (u + 1) < u1;
        const AttnU nu = attn_decode(has_next ? u + 1 : u);
        v4u n0, n1, n2, n3; bf16x8 nq0 = qf0, nq1 = qf1;
        if (has_next) { ATT_LOAD_BLOCK(nu, nu.blk, n0, n1, n2, n3); ATT_LOAD_Q(nu, nq0, nq1); }
        const int d = 1 << cu.dsh, blk = cu.blk, h = cu.h, gp = cu.gp; const size_t rowb = (size_t)cu.b * SEQ_;
        const LAS unsigned char* Kp = L + sp * SLOT_B; const LAS unsigned char* Kc = L + sc * SLOT_B;
        f32x4 s[9]; float mx = -INFINITY;
#pragma unroll
        for (int jt = 0; jt < 9; ++jt) { const int kc0 = 16 * wave + 16 * jt; const LAS unsigned char* kp = (kc0 < 128 ? Kp + kc0 * 144 : Kc + (kc0 - 128) * 144) + fr * 144 + 16 * g;
            const bf16x8 k0 = *(const LAS bf16x8*)kp, k1 = *(const LAS bf16x8*)(kp + 64);
            f32x4 a = ZERO4; a = mfma16(k0, qf0, a); a = mfma16(k1, qf1, a);
#pragma unroll
            for (int e = 0; e < 4; ++e) { const int rel = 16 * jt + 4 * g + e - fr; const int kc = kc0 + 4 * g + e;
                const bool ok = (rel >= 0) && (rel <= 128) && (blk > 0 || kc >= 128);
                a[e] = ok ? a[e] : -INFINITY; mx = fmaxf(mx, a[e]); }
            s[jt] = a; }
        mx = fmaxf(mx, shfl_idx(mx, lane ^ 16)); mx = fmaxf(mx, shfl_idx(mx, lane ^ 32));
        float lsum = 0.f;
#pragma unroll
        for (int jt = 0; jt < 9; ++jt)
#pragma unroll
            for (int e = 0; e < 4; ++e) { const float pe = __builtin_amdgcn_exp2f(s[jt][e] - mx); s[jt][e] = pe; lsum += pe; }
        lsum += shfl_idx(lsum, lane ^ 16); lsum += shfl_idx(lsum, lane ^ 32);
        f32x4 o[4];
#pragma unroll
        for (int dt = 0; dt < 4; ++dt) o[dt] = ZERO4;
#pragma unroll
        for (int st = 0; st < 5; ++st) { const int t0 = 2 * st, t1 = (2 * st + 1) < 9 ? (2 * st + 1) : 8;
            v4u pw; pw.x = cvt_pk_bf16(s[t0][0], s[t0][1]); pw.y = cvt_pk_bf16(s[t0][2], s[t0][3]);
            if (st < 4) { pw.z = cvt_pk_bf16(s[t1][0], s[t1][1]); pw.w = cvt_pk_bf16(s[t1][2], s[t1][3]); } else { pw.z = 0u; pw.w = 0u; }
            const bf16x8 pa = __builtin_bit_cast(bf16x8, pw);
            const int ka = 16 * wave + 16 * t0, kb = 16 * wave + 16 * t1;
            const LAS unsigned char* va = (ka < 128 ? Kp + ka * 144 : Kc + (ka - 128) * 144) + SLOT_V + (4 * g + q4) * 144 + 8 * p;
            const LAS unsigned char* vb = (kb < 128 ? Kp + kb * 144 : Kc + (kb - 128) * 144) + SLOT_V + (4 * g + q4) * 144 + 8 * p;
#pragma unroll
            for (int dt = 0; dt < 4; ++dt) { const s16x4 v0 = tr16(va + 32 * dt); const s16x4 v1 = (st < 4) ? tr16(vb + 32 * dt) : v0;
                o[dt] = mfma16(pa, cat8(v0, v1), o[dt]); } }
        const float lse = mx + __builtin_amdgcn_logf(lsum);
        const float inv = __builtin_amdgcn_rcpf(lsum);
        float invq[4];
#pragma unroll
        for (int e = 0; e < 4; ++e) invq[e] = shfl_idx(inv, 4 * g + e);
        const size_t qrow = rowb + (size_t)(128 * blk + 16 * wave + fr) * d + cu.r;
        if (g == 0) LSE[((size_t)gp * T_ + qrow) * 8 + h] = lse;
#pragma unroll
        for (int e = 0; e < 4; ++e) { const size_t orow = rowb + (size_t)(128 * blk + 16 * wave + 4 * g + e) * d + cu.r;
#pragma unroll
            for (int dt = 0; dt < 4; ++dt) OG[((size_t)gp * T_ + orow) * 512 + h * 64 + 16 * dt + fr] = (bf16)(cvt_pk_bf16(o[dt][e] * invq[e], 0.f) & 0xffffu); }
        if (has_next) ATT_WRITE_BLOCK(sf, n0, n1, n2, n3);
        __syncthreads();
        { const int t = sp; sp = sc; sc = sf; sf = t; }
        cu = nu; qf0 = nq0; qf1 = nq1;
    }
#undef ATT_LOAD_BLOCK
#undef ATT_WRITE_BLOCK
#undef ATT_LOAD_Q
}
__device__ __forceinline__ void combine_phase(KArgs A, int vcu_, int G, int wave_sgpr) {
    PHASE_IDS();
    unsigned char* ws = A->ws; const bf16* OG = (const bf16*)(ws + WS_OG); const float* LSE = (const float*)(ws + WS_LSE); bf16* YA = (bf16*)(ws + WS_YA);
    for (int i = vcu * 512 + tid; i < T_ * 64; i += G * 512) { const int tk = i >> 6, ch = i & 63, h = ch >> 3;
        const float l0 = LSE[((size_t)0 * T_ + tk) * 8 + h], l1 = LSE[((size_t)1 * T_ + tk) * 8 + h], l2 = LSE[((size_t)2 * T_ + tk) * 8 + h];
        const float mm = fmaxf(l0, fmaxf(l1, l2)); float w0 = __builtin_amdgcn_exp2f(l0 - mm), w1 = __builtin_amdgcn_exp2f(l1 - mm), w2 = __builtin_amdgcn_exp2f(l2 - mm); const float iw = __builtin_amdgcn_rcpf(w0 + w1 + w2); w0 *= iw; w1 *= iw; w2 *= iw;
        const v4u a = *(const v4u*)(OG + ((size_t)0 * T_ + tk) * 512 + ch * 8), bq = *(const v4u*)(OG + ((size_t)1 * T_ + tk) * 512 + ch * 8), c = *(const v4u*)(OG + ((size_t)2 * T_ + tk) * 512 + ch * 8);
        v4u o;
        o.x = cvt_pk_bf16(w0 * bflo(a.x) + w1 * bflo(bq.x) + w2 * bflo(c.x), w0 * bfhi(a.x) + w1 * bfhi(bq.x) + w2 * bfhi(c.x));
        o.y = cvt_pk_bf16(w0 * bflo(a.y) + w1 * bflo(bq.y) + w2 * bflo(c.y), w0 * bfhi(a.y) + w1 * bfhi(bq.y) + w2 * bfhi(c.y));
        o.z = cvt_pk_bf16(w0 * bflo(a.z) + w1 * bflo(bq.z) + w2 * bflo(c.z), w0 * bfhi(a.z) + w1 * bfhi(bq.z) + w2 * bfhi(c.z));
        o.w = cvt_pk_bf16(w0 * bflo(a.w) + w1 * bflo(bq.w) + w2 * bflo(c.w), w0 * bfhi(a.w) + w1 * bfhi(bq.w) + w2 * bfhi(c.w));
        *(v4u*)(YA + (size_t)tk * 512 + ch * 8) = o; }
}
__device__ __forceinline__ void final_norm_phase(KArgs A, int vcu_, int G, int wave_sgpr) {
    PHASE_IDS();
    const float* ss = (const float*)(A->ws + WS_SS1); const int gw = vcu * NWAVES + wave, NGW = G * NWAVES;
    for (int m = gw; m < T_; m += NGW) { const f32x4 pp = *(const f32x4*)(ss + (size_t)m * 4); const float rs = rsqrtf(((pp[0] + pp[1]) + (pp[2] + pp[3])) * (1.0f / 1024.0f) + 1e-6f);
        f32x4* xr = (f32x4*)(A->out + (size_t)m * DM_) + lane; const f32x4* wr_ = (const f32x4*)A->final_norm_w + lane;
#pragma unroll
        for (int j = 0; j < 4; ++j) xr[64 * j] = xr[64 * j] * rs * wr_[64 * j]; }
}

#ifndef PROBE_DUP
#define PROBE_DUP 0
#endif
__global__ void __launch_bounds__(NWAVES * 64, 2) fwd_megakernel(Args args_by_value) {
    extern __shared__ __attribute__((aligned(16))) unsigned char lds[];
    LAS unsigned char* L = (LAS unsigned char*)lds;
    volatile LAS unsigned* MISC = (volatile LAS unsigned*)(L + MISC_OFF);
    const int tid = threadIdx.x; const int wave = __builtin_amdgcn_readfirstlane(tid >> 6);
    const int G = gridDim.x, bx = blockIdx.x; const int vcu = (G % 8 == 0) ? (bx % 8) * (G / 8) + bx / 8 : bx;
    gu32* ctl = (gu32*)(kargs()->ws + WS_CTL);
    for (int u = tid; u < (LDS_BYTES - LDSCTL_OFF) / 4; u += NWAVES * 64) ((LAS unsigned*)(L + LDSCTL_OFF))[u] = 0u;
    __syncthreads();
    XcdBarrier bar = xcd_barrier_post((unsigned*)(ctl + CW_BAR), MISC + 8, wave);
#define GRID_BAR() xcd_barrier(bar)
#pragma unroll 1
    for (int layer = 0; layer < 2; ++layer) {
        p0_weights(kargs(), layer, L, vcu, G, wave);
        if (PROBE_DUP & 1) { __syncthreads(); p0_weights(kargs(), layer, L, vcu, G, wave); }
        if (layer == 0) p0_xprep(kargs(), vcu, G, wave);
        GRID_BAR();
        { KArgs A = kargs(); unsigned char* ws = A->ws; pg8::bf16_t* XB = (pg8::bf16_t*)(ws + WS_XB); float* SS1 = (float*)(ws + WS_SS1); float* SS2 = (float*)(ws + WS_SS2); (void)XB; (void)SS1; (void)SS2;
          pg8::Gemm g{XB, (const pg8::bf16_t*)(ws + WS_WIN), T_, NINP_, DM_}; pg8::StaticOrder S; S.init(T_, NINP_, G, bx);
          pg8::EpiInProj E{(pg8::bf16_t*)(ws + WS_Z), (float*)(ws + WS_GATES), SS1, (const float*)(ws + WS_BIAS), (const float*)(ws + WS_ROPE), 1};
          pg8::gemm_phase<pg8::EpiInProj, pg8::StaticOrder, true, true>(L, g, S, E, wave);
          if (PROBE_DUP & 2) { GRID_BAR(); pg8::gemm_phase<pg8::EpiInProj, pg8::StaticOrder, true, true>(L, g, S, E, wave); }
          if (PROBE_DUP & 2048) { GRID_BAR(); pg8::EpiInProj E2 = E; E2.st = (G == 12345); pg8::gemm_phase<pg8::EpiInProj, pg8::StaticOrder, true, true>(L, g, S, E2, wave); }
          if (PROBE_DUP & 1024) { GRID_BAR(); pg8::EpiNull EN{A->out, G == 12345}; pg8::gemm_phase<pg8::EpiNull, pg8::StaticOrder, true, true>(L, g, S, EN, wave); } }
        GRID_BAR();
        mlstm_summary_phase(kargs(), layer, L, vcu, G, wave);
        if (PROBE_DUP & 4) { GRID_BAR(); mlstm_summary_phase(kargs(), layer, L, vcu, G, wave); }
        GRID_BAR();
        mlstm_scan_phase(kargs(), vcu, G, wave);
        GRID_BAR();
        if (PROBE_DUP & 32) { mlstm_output_phase(kargs(), layer, L, vcu, G, wave, G == 12345); GRID_BAR(); }
        mlstm_output_phase(kargs(), layer, L, vcu, G, wave);
        GRID_BAR();
        attn_phase(kargs(), L, vcu, G, wave);
        if (PROBE_DUP & 8) { GRID_BAR(); attn_phase(kargs(), L, vcu, G, wave); }
        if (PROBE_DUP & 64) { for (int i = 0; i < 10; ++i) GRID_BAR(); }
        GRID_BAR();
        combine_phase(kargs(), vcu, G, wave);
        if (PROBE_DUP & 16) { GRID_BAR(); combine_phase(kargs(), vcu, G, wave); }
        GRID_BAR();
        { KArgs A = kargs(); unsigned char* ws = A->ws; pg8::bf16_t* XB = (pg8::bf16_t*)(ws + WS_XB); float* SS1 = (float*)(ws + WS_SS1); float* SS2 = (float*)(ws + WS_SS2); (void)XB; (void)SS1; (void)SS2;
          pg8::Gemm g{(const pg8::bf16_t*)(ws + WS_YA), (const pg8::bf16_t*)(ws + WS_PA), T_, DM_, 512}; pg8::StaticOrder S; S.init(T_, DM_, G, bx);
          pg8::EpiX1 E{(pg8::bf16_t*)(ws + WS_SGA)};
          pg8::gemm_phase<pg8::EpiX1, pg8::StaticOrder, true, true>(L, g, S, E, wave); }
        VM_WAIT(); __syncthreads(); __builtin_amdgcn_fence(__ATOMIC_ACQUIRE, "agent"); VM_WAIT(); __syncthreads();
        { KArgs A = kargs(); unsigned char* ws = A->ws; pg8::bf16_t* XB = (pg8::bf16_t*)(ws + WS_XB); float* SS1 = (float*)(ws + WS_SS1); float* SS2 = (float*)(ws + WS_SS2); (void)XB; (void)SS1; (void)SS2;
          pg8::Gemm g{(const pg8::bf16_t*)(ws + WS_YB), (const pg8::bf16_t*)(ws + WS_PB), T_, DM_, 512}; pg8::StaticOrder S; S.init(T_, DM_, G, bx);
          pg8::EpiX2 E{(pg8::bf16_t*)(ws + WS_SGA), (const pg8::bf16_t*)(ws + WS_SGB)};
          pg8::gemm_phase<pg8::EpiX2, pg8::StaticOrder, true, true>(L, g, S, E, wave); }
        GRID_BAR();
        { KArgs A = kargs(); unsigned char* ws = A->ws; pg8::bf16_t* XB = (pg8::bf16_t*)(ws + WS_XB); float* SS1 = (float*)(ws + WS_SS1); float* SS2 = (float*)(ws + WS_SS2); (void)XB; (void)SS1; (void)SS2;
          pg8::Gemm g{(const pg8::bf16_t*)(ws + WS_SGA), (const pg8::bf16_t*)(ws + WS_WOUT), T_, DM_, DM_}; pg8::StaticOrder S; S.init(T_, DM_, G, bx);
          pg8::EpiResid E{layer == 0 ? A->x : A->out, A->out, XB, SS2};
          pg8::gemm_phase<pg8::EpiResid, pg8::StaticOrder, false, true>(L, g, S, E, wave); }
        GRID_BAR();
        { KArgs A = kargs(); unsigned char* ws = A->ws; pg8::bf16_t* XB = (pg8::bf16_t*)(ws + WS_XB); float* SS1 = (float*)(ws + WS_SS1); float* SS2 = (float*)(ws + WS_SS2); (void)XB; (void)SS1; (void)SS2;
          pg8::Gemm g{XB, (const pg8::bf16_t*)(ws + WS_W1), T_, FF_, DM_}; pg8::StaticOrder S; S.init(T_, FF_, G, bx);
          pg8::EpiFF1 E{(pg8::bf16_t*)(ws + WS_H), SS2, 0};
          pg8::gemm_phase<pg8::EpiFF1, pg8::StaticOrder, true, true>(L, g, S, E, wave);
          if (PROBE_DUP & 4096) { GRID_BAR(); pg8::EpiFF1 E2 = E; E2.mode = (G == 12345) ? 0 : 1; E2.H = (pg8::bf16_t*)(ws + WS_H) + (G == 12345 ? 0 : 0); pg8::gemm_phase<pg8::EpiFF1, pg8::StaticOrder, true, true>(L, g, S, E2, wave); GRID_BAR(); pg8::gemm_phase<pg8::EpiFF1, pg8::StaticOrder, true, true>(L, g, S, E, wave); }
          if (PROBE_DUP & 8192) { GRID_BAR(); pg8::EpiFF1 E2 = E; E2.mode = (G == 12345) ? 0 : 2; pg8::gemm_phase<pg8::EpiFF1, pg8::StaticOrder, true, true>(L, g, S, E2, wave); }
          if (PROBE_DUP & 128) { GRID_BAR(); pg8::gemm_phase<pg8::EpiFF1, pg8::StaticOrder, true, true>(L, g, S, E, wave); } }
        GRID_BAR();
        { KArgs A = kargs(); unsigned char* ws = A->ws; pg8::bf16_t* XB = (pg8::bf16_t*)(ws + WS_XB); float* SS1 = (float*)(ws + WS_SS1); float* SS2 = (float*)(ws + WS_SS2); (void)XB; (void)SS1; (void)SS2;
          pg8::Gemm g{(const pg8::bf16_t*)(ws + WS_H), (const pg8::bf16_t*)(ws + WS_W2), T_, DM_, FF_}; pg8::StaticOrder S; S.init(T_, DM_, G, bx);
          pg8::EpiResid E{A->out, A->out, XB, SS1};
          if (PROBE_DUP & 256) { pg8::EpiNull EN{A->out, G == 12345}; pg8::gemm_phase<pg8::EpiNull, pg8::StaticOrder, true, true>(L, g, S, EN, wave); GRID_BAR(); }
          if (PROBE_DUP & 512) { pg8::Gemm g2{XB, (const pg8::bf16_t*)(ws + WS_WOUT), T_, DM_, DM_}; pg8::EpiNull EN{A->out, G == 12345}; pg8::gemm_phase<pg8::EpiNull, pg8::StaticOrder, true, true>(L, g2, S, EN, wave); GRID_BAR(); }
          pg8::gemm_phase<pg8::EpiResid, pg8::StaticOrder, false, true>(L, g, S, E, wave); }
        GRID_BAR();
    }
    final_norm_phase(kargs(), vcu, G, wave);
}

extern "C" void kernel_launch(void* const* d_in, const int* in_sizes, int n_in, void* d_out, int out_size, void* d_ws, size_t ws_size, hipStream_t stream) {
    static int grid = 0;
    if (grid == 0) {
        int dev = 0, cus = 0;
        if (n_in != 15 || out_size != T_ * DM_ || ws_size < WS_END) { fprintf(stderr, "kernel_launch: unexpected shapes (n_in %d, out %d, ws %zu)\n", n_in, out_size, ws_size); grid = -1; return; }
        if (hipGetDevice(&dev) != hipSuccess || hipDeviceGetAttribute(&cus, hipDeviceAttributeMultiprocessorCount, dev) != hipSuccess) { grid = -1; return; }
        if (hipFuncSetAttribute((const void*)fwd_megakernel, hipFuncAttributeMaxDynamicSharedMemorySize, LDS_BYTES) != hipSuccess) { grid = -1; return; }
        grid = cus;
    }
    if (grid < 0) return;
    (void)hipMemsetAsync((char*)d_ws + WS_CTL, 0, CTL_ZERO_BYTES, stream);
    Args a{};
    a.x = (const float*)d_in[0]; a.pos = (const int*)d_in[1]; a.norm_mix_w = (const float*)d_in[2]; a.w_in = (const float*)d_in[3]; a.b_in = (const float*)d_in[4];
    a.conv_w = (const float*)d_in[5]; a.conv_b = (const float*)d_in[6]; a.mlstm_norm_w = (const float*)d_in[7]; a.w_proj_att = (const float*)d_in[8]; a.w_proj_mlstm = (const float*)d_in[9];
    a.w_out = (const float*)d_in[10]; a.norm_mlp_w = (const float*)d_in[11]; a.w_ff1 = (const float*)d_in[12]; a.w_ff2 = (const float*)d_in[13]; a.final_norm_w = (const float*)d_in[14];
    a.out = (float*)d_out; a.ws = (unsigned char*)d_ws;
    hipLaunchKernelGGL(fwd_megakernel, dim3(grid), dim3(NWAVES * 64), LDS_BYTES, stream, a);
}
```
